# Optimizing an MI355X kernel written in HIP

```python
import jax
import jax.numpy as jnp
from jax import lax
import numpy as np

D_MODEL = 1024
BATCH = 2
SEQ = 8192
DEPTH = 2
DEC_BATCH = 128
DEC_SEQ = 8
PAST_LEN = 16384
PAGE_SIZE = 128

HEAD_DIM = 64
N_HEADS = D_MODEL // HEAD_DIM
N_KV_HEADS = N_HEADS // 4
Q_REP = N_HEADS // N_KV_HEADS
ROT_DIM = HEAD_DIM // 4
ROPE_THETA = 500000.0
WINDOW = 128
ATTN_BLOCK = 128
CONF_WIDTH = D_MODEL // 2
CONF_CONV_W = 31
SC_WIDTH = D_MODEL // 2
SC_CONV_W = 3
GMLP_WIDTH = D_MODEL // 2
GMLP_CHUNK = 128
GMLP_GROUPS = 8
GMLP_GROUP_DIM = GMLP_WIDTH // GMLP_GROUPS
N_BRANCHES = 4
D_FF = 4 * D_MODEL
EPS = 1e-6

COL_SIZES = (N_HEADS * HEAD_DIM, N_KV_HEADS * HEAD_DIM, N_KV_HEADS * HEAD_DIM,
             2 * CONF_WIDTH, 3 * SC_WIDTH, 2 * GMLP_WIDTH, N_BRANCHES * D_MODEL)
IN_COLS = sum(COL_SIZES)

kernel_name = 'hybrid_gated_branch_decoder'


def rms_norm(x, g):
    xf = x.astype(jnp.float32)
    y = xf * lax.rsqrt(jnp.mean(xf * xf, axis=-1, keepdims=True) + EPS)
    return (y * g.astype(jnp.float32)).astype(x.dtype)


def layer_norm(x, g, b):
    xf = x.astype(jnp.float32)
    mu = jnp.mean(xf, axis=-1, keepdims=True)
    xc = xf - mu
    y = xc * lax.rsqrt(jnp.mean(xc * xc, axis=-1, keepdims=True) + EPS)
    return (y * g.astype(jnp.float32) + b.astype(jnp.float32)).astype(x.dtype)


def split_columns(proj):
    idx = []
    acc = 0
    for s in COL_SIZES[:-1]:
        acc += s
        idx.append(acc)
    return jnp.split(proj, idx, axis=-1)


def rope_partial(x, pos):
    half = ROT_DIM // 2
    inv_freq = jnp.power(ROPE_THETA, -jnp.arange(half, dtype=jnp.float32) * 2.0 / ROT_DIM)
    ang = pos.astype(jnp.float32)[:, None] * inv_freq[None, :]
    cos = jnp.cos(ang)[:, None, :]
    sin = jnp.sin(ang)[:, None, :]
    xr = x[..., :ROT_DIM].astype(jnp.float32)
    x1, x2 = xr[..., :half], xr[..., half:]
    rot = jnp.concatenate([x1 * cos - x2 * sin, x2 * cos + x1 * sin], axis=-1).astype(x.dtype)
    return jnp.concatenate([rot, x[..., ROT_DIM:]], axis=-1)


def sink_attention(q, k, v, mask, sinks):
    s = jnp.einsum('...qgrd,...kgd->...grqk', q, k,
                   preferred_element_type=jnp.float32) * (HEAD_DIM ** -0.5)
    s = jnp.where(mask, s, -1e30)
    sink = jnp.broadcast_to(sinks.astype(jnp.float32).reshape(N_KV_HEADS, Q_REP, 1, 1),
                            s.shape[:-1] + (1,))
    p = jax.nn.softmax(jnp.concatenate([s, sink], axis=-1), axis=-1)[..., :-1]
    return jnp.einsum('...grqk,...kgd->...qgrd', p.astype(v.dtype), v)


def attn_prompt(q, k, v, sinks):
    bsz, seq = q.shape[0], q.shape[1]
    nb = seq // ATTN_BLOCK
    qb = q.reshape(bsz, nb, ATTN_BLOCK, N_KV_HEADS, Q_REP, HEAD_DIM)

    def band(t):
        tp = jnp.pad(t, ((0, 0), (ATTN_BLOCK, 0), (0, 0), (0, 0)))
        tp = tp.reshape(bsz, nb + 1, ATTN_BLOCK, N_KV_HEADS, HEAD_DIM)
        return jnp.concatenate([tp[:, :-1], tp[:, 1:]], axis=2)

    kb, vb = band(k), band(v)
    qpos = jnp.arange(seq).reshape(nb, ATTN_BLOCK)
    kpos = jnp.arange(-ATTN_BLOCK, seq).reshape(nb + 1, ATTN_BLOCK)
    kpos = jnp.concatenate([kpos[:-1], kpos[1:]], axis=1)
    d = qpos[:, :, None] - kpos[:, None, :]
    mask = (d >= 0) & (d <= WINDOW) & (kpos[:, None, :] >= 0)
    o = sink_attention(qb, kb, vb, mask[:, None, None], sinks)
    return o.reshape(bsz, seq, N_HEADS * HEAD_DIM)


def attn_sample(q, k, v, k_buf, v_buf, sinks):
    bsz, seq = q.shape[0], q.shape[1]
    wlen = k_buf.shape[1]
    kc = jnp.concatenate([k_buf.astype(k.dtype), k], axis=1)
    vc = jnp.concatenate([v_buf.astype(v.dtype), v], axis=1)
    qpos = PAST_LEN + jnp.arange(seq)
    kpos = PAST_LEN - wlen + jnp.arange(wlen + seq)
    d = qpos[:, None] - kpos[None, :]
    mask = (d >= 0) & (d <= WINDOW)
    o = sink_attention(q.reshape(bsz, seq, N_KV_HEADS, Q_REP, HEAD_DIM), kc, vc, mask, sinks)
    return o.reshape(bsz, seq, N_HEADS * HEAD_DIM), kc[:, -wlen:], vc[:, -wlen:]


def causal_dwconv(u, buf, w):
    ch = u.shape[-1]
    wlen = w.shape[0]
    cat = jnp.concatenate([buf.astype(u.dtype), u], axis=1)
    out = lax.conv_general_dilated(cat, w[:, None, :].astype(u.dtype), (1,), 'VALID',
                                   dimension_numbers=('NWC', 'WIO', 'NWC'),
                                   feature_group_count=ch)
    return out, cat[:, -(wlen - 1):]


def chunk_spatial_gate(u, v, w_s, b_s):
    bsz, seq = v.shape[0], v.shape[1]
    pad = (-seq) % GMLP_CHUNK
    nc = (seq + pad) // GMLP_CHUNK
    vp = jnp.pad(v, ((0, 0), (0, pad), (0, 0)))
    vp = vp.reshape(bsz, nc, GMLP_CHUNK, GMLP_GROUPS, GMLP_GROUP_DIM)
    causal = jnp.tril(jnp.ones((GMLP_CHUNK, GMLP_CHUNK), dtype=bool))
    wm = jnp.where(causal, w_s, 0).astype(v.dtype)
    z = jnp.einsum('gts,bcsgd->bctgd', wm, vp) + b_s.T[:, :, None].astype(v.dtype)
    z = z.reshape(bsz, nc * GMLP_CHUNK, GMLP_WIDTH)[:, :seq]
    return u * z


def trunk_layer(x, c, pos, conv_a_buf, conv_b_buf, kv_buf, lp):
    bsz, seq = x.shape[0], x.shape[1]
    mod = jax.nn.silu(c) @ lp['w_ada'] + lp['b_ada']
    shift1, scale1, gate1, shift2, scale2, gate2 = jnp.split(mod[:, None, :], 6, axis=-1)
    h = rms_norm(x, lp['norm1_g']) * (1 + scale1) + shift1
    q, k, v, a_in, b_in, c_in, g_in = split_columns(h @ lp['w_in'])

    q = rope_partial(rms_norm(q.reshape(bsz, seq, N_HEADS, HEAD_DIM), lp['q_norm_g']), pos)
    k = rope_partial(rms_norm(k.reshape(bsz, seq, N_KV_HEADS, HEAD_DIM), lp['k_norm_g']), pos)
    v = v.reshape(bsz, seq, N_KV_HEADS, HEAD_DIM)
    if kv_buf is None:
        attn = attn_prompt(q, k, v, lp['attn_sinks'])
        new_k, new_v = k[:, -WINDOW:], v[:, -WINDOW:]
    else:
        attn, new_k, new_v = attn_sample(q, k, v, kv_buf[0], kv_buf[1], lp['attn_sinks'])
    attn_out = attn @ lp['w_attn_o']

    a_val, a_gate = jnp.split(a_in, 2, axis=-1)
    glu = a_val * jax.nn.sigmoid(a_gate)
    a_conv, new_conv_a = causal_dwconv(glu, conv_a_buf, lp['conv_a_w'])
    a_conv = a_conv + lp['conv_a_b']
    a_out = jax.nn.silu(layer_norm(a_conv, lp['ln_a_g'], lp['ln_a_b'])) @ lp['w_a_out']

    b_gate, c_gate, h_sc = jnp.split(b_in, 3, axis=-1)
    sc, new_conv_b = causal_dwconv(c_gate * h_sc, conv_b_buf, lp['conv_b_w'])
    b_out = (b_gate * sc) @ lp['w_b_out']

    zc = jax.nn.gelu(c_in)
    u, vv = jnp.split(zc, 2, axis=-1)
    vv = layer_norm(vv, lp['ln_c_g'], lp['ln_c_b'])
    c_out = chunk_spatial_gate(u, vv, lp['w_spatial'], lp['b_spatial']) @ lp['w_c_out']

    g = jax.nn.sigmoid(g_in).reshape(bsz, seq, N_BRANCHES, D_MODEL)
    merged = (g[:, :, 0] * attn_out + g[:, :, 1] * a_out
              + g[:, :, 2] * b_out + g[:, :, 3] * c_out)
    x = x + gate1 * (merged @ lp['w_o'])

    h2 = rms_norm(x, lp['norm2_g']) * (1 + scale2) + shift2
    x = x + gate2 * (jnp.square(jax.nn.relu(h2 @ lp['w_up'])) @ lp['w_down'])
    return x, (new_conv_a, new_conv_b, new_k, new_v, vv)


def setup_inputs(seed: int = 0) -> dict:
    key = jax.random.key(seed)
    ks = jax.random.split(key, 40)
    f = jnp.float32

    def nrm(i, shape, scale=1.0):
        return jax.random.normal(ks[i], shape, f) * scale

    L = DEPTH
    return {
        'x_prompt': nrm(0, (BATCH, SEQ, D_MODEL)),
        'x_sample': nrm(1, (DEC_BATCH, DEC_SEQ, D_MODEL)),
        'c_prompt': nrm(2, (BATCH, D_MODEL)),
        'c_sample': nrm(3, (DEC_BATCH, D_MODEL)),
        'state_conv_a': nrm(4, (L, DEC_BATCH, CONF_CONV_W - 1, CONF_WIDTH), 0.5),
        'state_conv_b': nrm(5, (L, DEC_BATCH, SC_CONV_W - 1, SC_WIDTH)),
        'cache_k_win': nrm(6, (L, DEC_BATCH, WINDOW, N_KV_HEADS, HEAD_DIM)),
        'cache_v_win': nrm(7, (L, DEC_BATCH, WINDOW, N_KV_HEADS, HEAD_DIM)),
        'w_ada': nrm(8, (L, D_MODEL, 6 * D_MODEL), D_MODEL ** -0.5),
        'b_ada': nrm(9, (L, 6 * D_MODEL), 0.02),
        'norm1_g': 1.0 + nrm(10, (L, D_MODEL), 0.05),
        'norm2_g': 1.0 + nrm(11, (L, D_MODEL), 0.05),
        'w_in': nrm(12, (L, D_MODEL, IN_COLS), D_MODEL ** -0.5),
        'q_norm_g': 1.0 + nrm(13, (L, HEAD_DIM), 0.05),
        'k_norm_g': 1.0 + nrm(14, (L, HEAD_DIM), 0.05),
        'attn_sinks': nrm(15, (L, N_HEADS), 0.5),
        'w_attn_o': nrm(16, (L, N_HEADS * HEAD_DIM, D_MODEL), (N_HEADS * HEAD_DIM) ** -0.5),
        'conv_a_w': nrm(17, (L, CONF_CONV_W, CONF_WIDTH), CONF_CONV_W ** -0.5),
        'conv_a_b': nrm(18, (L, CONF_WIDTH), 0.02),
        'ln_a_g': 1.0 + nrm(19, (L, CONF_WIDTH), 0.05),
        'ln_a_b': nrm(20, (L, CONF_WIDTH), 0.02),
        'w_a_out': nrm(21, (L, CONF_WIDTH, D_MODEL), CONF_WIDTH ** -0.5),
        'conv_b_w': nrm(22, (L, SC_CONV_W, SC_WIDTH), SC_CONV_W ** -0.5),
        'w_b_out': nrm(23, (L, SC_WIDTH, D_MODEL), SC_WIDTH ** -0.5),
        'ln_c_g': 1.0 + nrm(24, (L, GMLP_WIDTH), 0.05),
        'ln_c_b': nrm(25, (L, GMLP_WIDTH), 0.02),
        'w_spatial': nrm(26, (L, GMLP_GROUPS, GMLP_CHUNK, GMLP_CHUNK), GMLP_CHUNK ** -0.5),
        'b_spatial': 1.0 + nrm(27, (L, GMLP_GROUPS, GMLP_CHUNK), 0.05),
        'w_c_out': nrm(28, (L, GMLP_WIDTH, D_MODEL), GMLP_WIDTH ** -0.5),
        'w_o': nrm(29, (L, D_MODEL, D_MODEL), D_MODEL ** -0.5),
        'w_up': nrm(30, (L, D_MODEL, D_FF), D_MODEL ** -0.5),
        'w_down': nrm(31, (L, D_FF, D_MODEL), D_FF ** -0.5),
    }


def reference(x_prompt, x_sample, c_prompt, c_sample, state_conv_a, state_conv_b,
              cache_k_win, cache_v_win, w_ada, b_ada, norm1_g, norm2_g, w_in,
              q_norm_g, k_norm_g, attn_sinks, w_attn_o, conv_a_w, conv_a_b, ln_a_g, ln_a_b,
              w_a_out, conv_b_w, w_b_out, ln_c_g, ln_c_b, w_spatial, b_spatial, w_c_out,
              w_o, w_up, w_down):
    pos_p = jnp.arange(x_prompt.shape[1])
    pos_s = PAST_LEN + jnp.arange(x_sample.shape[1])
    bp = x_prompt.shape[0]
    xp, xs = x_prompt, x_sample
    pa_l, sa_l, pb_l, sb_l, pk_l, sk_l, pv_l, sv_l, sg_l = [], [], [], [], [], [], [], [], []
    for l in range(DEPTH):
        lp = {'w_ada': w_ada[l], 'b_ada': b_ada[l], 'norm1_g': norm1_g[l], 'norm2_g': norm2_g[l],
              'w_in': w_in[l], 'q_norm_g': q_norm_g[l], 'k_norm_g': k_norm_g[l],
              'attn_sinks': attn_sinks[l], 'w_attn_o': w_attn_o[l], 'conv_a_w': conv_a_w[l],
              'conv_a_b': conv_a_b[l], 'ln_a_g': ln_a_g[l], 'ln_a_b': ln_a_b[l],
              'w_a_out': w_a_out[l], 'conv_b_w': conv_b_w[l], 'w_b_out': w_b_out[l],
              'ln_c_g': ln_c_g[l], 'ln_c_b': ln_c_b[l], 'w_spatial': w_spatial[l],
              'b_spatial': b_spatial[l], 'w_c_out': w_c_out[l], 'w_o': w_o[l],
              'w_up': w_up[l], 'w_down': w_down[l]}
        zero_a = jnp.zeros((bp, CONF_CONV_W - 1, CONF_WIDTH), xp.dtype)
        zero_b = jnp.zeros((bp, SC_CONV_W - 1, SC_WIDTH), xp.dtype)
        xp, (pa, pb, pk, pv, _) = trunk_layer(xp, c_prompt, pos_p, zero_a, zero_b, None, lp)
        xs, (sa, sb, sk, sv, sg) = trunk_layer(xs, c_sample, pos_s, state_conv_a[l],
                                               state_conv_b[l], (cache_k_win[l], cache_v_win[l]), lp)
        pa_l.append(pa); sa_l.append(sa); pb_l.append(pb); sb_l.append(sb)
        pk_l.append(pk); sk_l.append(sk); pv_l.append(pv); sv_l.append(sv); sg_l.append(sg)
    return (xp, xs, jnp.stack(pa_l), jnp.stack(sa_l), jnp.stack(pb_l), jnp.stack(sb_l),
            jnp.stack(pk_l), jnp.stack(sk_l), jnp.stack(pv_l), jnp.stack(sv_l), jnp.stack(sg_l))
```

```cpp
#include <hip/hip_runtime.h>
#include <hip/hip_cooperative_groups.h>
#include <cstdio>
#include <cstdint>
namespace cg = cooperative_groups;
namespace pg8 {
#define PG8_LAS __attribute__((address_space(3)))
typedef unsigned short bf16_t;
typedef short bf16x8 __attribute__((ext_vector_type(8)));
typedef float f32x4 __attribute__((ext_vector_type(4)));
typedef unsigned u32x4 __attribute__((ext_vector_type(4)));
constexpr int BM = 256, BK = 64, HALF = 128, HTB = HALF * BK * 2  , STAGE_BYTES = 8 * HTB, NXCD = 8, WGM = 8;

__host__ __device__ __forceinline__ int lds_byte(int r, int c) { const int st = (r >> 4) * 2 + (c >> 5), rr = r & 15, cc = c & 31, ob = rr * 64 + cc * 2; return st * 1024 + (ob ^ (((ob >> 9) & 1) << 5)); }
__host__ __device__ __forceinline__ void stage_rc(int b, int& R, int& C) { const int st = b / 1024, sb = b % 1024, swz = sb ^ (((sb >> 9) & 1) << 5); R = (st >> 1) * 16 + swz / 64; C = (st & 1) * 32 + (swz % 64) / 2; }
__host__ __device__ __forceinline__ int perm32(int rho) { const int n = rho >> 4, i = rho & 15; return 8 * (i >> 2) + 4 * n + (i & 3); }

struct Unit { int pm, pn; };
struct Gemm { const bf16_t* A; const bf16_t* Bt; int M, N, K, lda, ldb; };

struct StaticOrder {
    int nM, nN, nwg, G, c;
    __host__ __device__ void init(int M, int N, int G_, int c_) { nM = M / BM; nN = N / BM; nwg = nM * nN; G = G_; c = c_; }
    __host__ __device__ bool next(int i, Unit& u) const {
        const long L = (long)i * G + c; if (L >= nwg) return false;
        int wgid = (int)L; { const int q = nwg / NXCD, r = nwg % NXCD, xcd = wgid % NXCD, off = wgid / NXCD; wgid = (xcd < r ? xcd * (q + 1) : r * (q + 1) + (xcd - r) * q) + off; }
        const int nig = WGM * nN, gid = wgid / nig, fm = gid * WGM, gsz = (nM - fm) < WGM ? (nM - fm) : WGM;
        u.pm = fm + ((wgid % nig) % gsz); u.pn = (wgid % nig) / gsz; return true;
    }
    __device__ __forceinline__ void a_ready(const Unit&) const {}
    __device__ __forceinline__ void done(const Unit&) const {}
};
__device__ __forceinline__ unsigned cvt_pk_bf16(float lo, float hi) { unsigned r; asm volatile("v_cvt_pk_bf16_f32 %0, %1, %2" : "=v"(r) : "v"(lo), "v"(hi)); return r; }
typedef float f32x2 __attribute__((ext_vector_type(2)));
template <class Epi, class Sched, bool ALIGN_EPI = false, bool SP2 = false>
__device__ __forceinline__ void gemm_phase(PG8_LAS unsigned char* lds, const Gemm g, const Sched& S, const Epi& E, const int tid) {
    const int wid = __builtin_amdgcn_readfirstlane(tid >> 6), lane = tid & 63, wr = wid >> 2, wc = wid & 3, fr = lane & 15, fq = lane >> 4;
    const int K = g.K, nt = K / BK;
    unsigned voffA[2], voffB[2];
#pragma unroll
    for (int i = 0; i < 2; ++i) { int R, C; stage_rc(tid * 16 + i * 8192, R, C); const int Rb = Epi::PERM ? ((R & ~31) + perm32(R & 31)) : R;
        voffA[i] = (unsigned)(R * g.lda + C) * 2u; voffB[i] = (unsigned)(Rb * g.ldb + C) * 2u; }
    const size_t kstep = (size_t)(BK * 2);
    const size_t hstepA = (size_t)HALF * g.lda * 2, hstepB = (size_t)HALF * g.ldb * 2;
    const size_t tstepA = 2 * hstepA, tstepB = 2 * hstepB;
    const unsigned ldsw = (unsigned)wid * 1024u;
    const int aoff = lds_byte(wr * 64 + fr, fq * 8), boff = lds_byte(wc * 32 + fr, fq * 8);
#define PG8_SA(b, h) (((b) * 2 + (h)) * HTB)
#define PG8_SB(b, h) ((4 + (b) * 2 + (h)) * HTB)
#define PG8_STAGE(bufoff, gbase, voff) do { _Pragma("unroll") for (int _i = 0; _i < 2; ++_i) \
        __builtin_amdgcn_global_load_lds((const unsigned*)((const char*)(gbase) + (voff)[_i]), (PG8_LAS unsigned*)(lds + (bufoff) + ldsw + _i * 8192), 16, 0, 0); } while (0)
#define PG8_LDA(dst, b, h) do { _Pragma("unroll") for (int m = 0; m < 4; ++m) _Pragma("unroll") for (int k = 0; k < 2; ++k) dst[m][k] = *(const PG8_LAS bf16x8*)(lds + PG8_SA(b, h) + aoff + m * 2048 + k * 1024); } while (0)
#define PG8_LDB(dst, b, h) do { _Pragma("unroll") for (int n = 0; n < 2; ++n) _Pragma("unroll") for (int k = 0; k < 2; ++k) dst[n][k] = *(const PG8_LAS bf16x8*)(lds + PG8_SB(b, h) + boff + n * 2048 + k * 1024); } while (0)
#define PG8_MMA(ai, bj, At, Bt) do { __builtin_amdgcn_s_setprio(1); _Pragma("unroll") for (int m = 0; m < 4; ++m) _Pragma("unroll") for (int n = 0; n < 2; ++n) _Pragma("unroll") for (int k = 0; k < 2; ++k) \
        acc[ai][bj][m][n] = __builtin_amdgcn_mfma_f32_16x16x32_bf16(Bt[n][k], At[m][k], acc[ai][bj][m][n], 0, 0, 0); __builtin_amdgcn_s_setprio(0); } while (0)
#define PG8_WAIT_V(n) asm volatile("s_waitcnt vmcnt(" #n ")" ::: "memory")
#define PG8_WAIT_L(n) asm volatile("s_waitcnt lgkmcnt(" #n ")" ::: "memory")
#define PG8_BAR __builtin_amdgcn_s_barrier()
#define PG8_SCHED __builtin_amdgcn_sched_barrier(0)
    Unit cur, nxt; int ui = 0;
    if (!S.next(0, cur)) return;
    f32x4 acc[2][2][4][2];
#pragma unroll
    for (int a = 0; a < 2; ++a)
#pragma unroll
        for (int b = 0; b < 2; ++b)
#pragma unroll
            for (int m = 0; m < 4; ++m)
#pragma unroll
                for (int n = 0; n < 2; ++n) acc[a][b][m][n] = (f32x4){0.f, 0.f, 0.f, 0.f};
    bf16x8 At[4][2], B0[2][2], B1[2][2];
    const char* cA = (const char*)g.A + (size_t)cur.pm * tstepA; const char* cB = (const char*)g.Bt + (size_t)cur.pn * tstepB;
    S.a_ready(cur);
    if constexpr (SP2) {
        PG8_STAGE(PG8_SB(0, 0), cB, voffB); PG8_STAGE(PG8_SB(0, 1), cB + hstepB, voffB); PG8_STAGE(PG8_SA(0, 0), cA, voffA); PG8_STAGE(PG8_SA(0, 1), cA + hstepA, voffA);
        if (wr == 1) PG8_BAR;
        PG8_WAIT_V(2); PG8_BAR;
        PG8_STAGE(PG8_SB(1, 0), cB + kstep, voffB); PG8_STAGE(PG8_SA(1, 0), cA + kstep, voffA); PG8_STAGE(PG8_SB(1, 1), cB + hstepB + kstep, voffB);
        PG8_WAIT_V(6); PG8_BAR;
    } else {
        PG8_STAGE(PG8_SB(0, 0), cB, voffB); PG8_STAGE(PG8_SA(0, 0), cA, voffA); PG8_STAGE(PG8_SB(0, 1), cB + hstepB, voffB); PG8_STAGE(PG8_SA(0, 1), cA + hstepA, voffA);
        if (wr == 1) PG8_BAR;
        PG8_WAIT_V(4); PG8_BAR;
        PG8_STAGE(PG8_SB(1, 0), cB + kstep, voffB); PG8_STAGE(PG8_SA(1, 0), cA + kstep, voffA); PG8_STAGE(PG8_SB(1, 1), cB + hstepB + kstep, voffB);
        PG8_WAIT_V(6); PG8_BAR;
    }
    for (;;) {
        const bool has_next = S.next(ui + 1, nxt);
        const char* nA = has_next ? (const char*)g.A + (size_t)nxt.pm * tstepA : cA; const char* nB = has_next ? (const char*)g.Bt + (size_t)nxt.pn * tstepB : cB;
        for (int t = 0; t < nt; t += 2) {
            const bool last = (t == nt - 2);
            const char* a1 = cA + (size_t)(t + 1) * kstep;
            const char* a2 = last ? nA : cA + (size_t)(t + 2) * kstep; const char* b2 = last ? nB : cB + (size_t)(t + 2) * kstep;
            const char* a3 = a2 + kstep; const char* b3 = b2 + kstep;
            if (last && has_next) S.a_ready(nxt);
            if constexpr (SP2) {
            PG8_LDB(B0, 0, 0); PG8_LDB(B1, 0, 1); PG8_SCHED; PG8_LDA(At, 0, 0); PG8_STAGE(PG8_SA(1, 1), a1 + hstepA, voffA);
            PG8_WAIT_V(8); PG8_WAIT_L(0); PG8_BAR; PG8_MMA(0, 0, At, B0); PG8_MMA(0, 1, At, B1); PG8_BAR; PG8_SCHED;
            PG8_LDA(At, 0, 1); PG8_STAGE(PG8_SB(0, 0), b2, voffB); PG8_STAGE(PG8_SB(0, 1), b2 + hstepB, voffB); PG8_STAGE(PG8_SA(0, 0), a2, voffA);
            PG8_WAIT_V(8); PG8_WAIT_L(0); PG8_BAR; PG8_MMA(1, 0, At, B0); PG8_MMA(1, 1, At, B1); PG8_BAR; PG8_SCHED;
            PG8_LDB(B0, 1, 0); PG8_LDB(B1, 1, 1); PG8_SCHED; PG8_LDA(At, 1, 0); PG8_STAGE(PG8_SA(0, 1), a2 + hstepA, voffA);
            PG8_WAIT_V(8); PG8_WAIT_L(0); PG8_BAR; PG8_MMA(0, 0, At, B0); PG8_MMA(0, 1, At, B1); PG8_BAR; PG8_SCHED;
            PG8_LDA(At, 1, 1); PG8_STAGE(PG8_SB(1, 0), b3, voffB); PG8_STAGE(PG8_SB(1, 1), b3 + hstepB, voffB); PG8_STAGE(PG8_SA(1, 0), a3, voffA);
            PG8_WAIT_V(8); PG8_WAIT_L(0); PG8_BAR; PG8_MMA(1, 0, At, B0); PG8_MMA(1, 1, At, B1); PG8_BAR; PG8_SCHED;
            } else {
            PG8_LDB(B0, 0, 0); PG8_SCHED; PG8_LDA(At, 0, 0); PG8_STAGE(PG8_SA(1, 1), a1 + hstepA, voffA);
            PG8_WAIT_L(8); PG8_BAR; PG8_WAIT_L(0); PG8_MMA(0, 0, At, B0); PG8_BAR; PG8_SCHED;
            PG8_LDB(B1, 0, 1); PG8_STAGE(PG8_SB(0, 0), b2, voffB);
            PG8_BAR; PG8_WAIT_L(0); PG8_MMA(0, 1, At, B1); PG8_BAR;
            PG8_LDA(At, 0, 1); PG8_STAGE(PG8_SA(0, 0), a2, voffA);
            PG8_BAR; PG8_WAIT_L(0); PG8_MMA(1, 0, At, B0); PG8_BAR; PG8_SCHED;
            PG8_STAGE(PG8_SB(0, 1), b2 + hstepB, voffB);
            PG8_WAIT_V(6); PG8_BAR; PG8_MMA(1, 1, At, B1); PG8_BAR;
            PG8_LDB(B0, 1, 0); PG8_SCHED; PG8_LDA(At, 1, 0); PG8_STAGE(PG8_SA(0, 1), a2 + hstepA, voffA);
            PG8_WAIT_L(8); PG8_BAR; PG8_WAIT_L(0); PG8_MMA(0, 0, At, B0); PG8_BAR; PG8_SCHED;
            PG8_LDB(B1, 1, 1); PG8_STAGE(PG8_SB(1, 0), b3, voffB);
            PG8_BAR; PG8_WAIT_L(0); PG8_MMA(0, 1, At, B1); PG8_BAR;
            PG8_LDA(At, 1, 1); PG8_STAGE(PG8_SA(1, 0), a3, voffA);
            PG8_BAR; PG8_WAIT_L(0); PG8_MMA(1, 0, At, B0); PG8_BAR; PG8_SCHED;
            PG8_STAGE(PG8_SB(1, 1), b3 + hstepB, voffB);
            PG8_WAIT_V(6); PG8_BAR; PG8_MMA(1, 1, At, B1); PG8_BAR;
            }
        }
        if constexpr (ALIGN_EPI) { if (wr == 0) PG8_BAR; }
        if constexpr (!Epi::AFTER_DRAIN) { E(acc, cur, wr, wc, fr, fq); S.done(cur); }
        if (!has_next) break;
#pragma unroll
        for (int a = 0; a < 2; ++a)
#pragma unroll
            for (int b = 0; b < 2; ++b)
#pragma unroll
                for (int m = 0; m < 4; ++m)
#pragma unroll
                    for (int n = 0; n < 2; ++n) acc[a][b][m][n] = (f32x4){0.f, 0.f, 0.f, 0.f};
        cur = nxt; cA = nA; cB = nB; ++ui;
        if constexpr (ALIGN_EPI) { if (wr == 1) PG8_BAR; }
    }
    PG8_WAIT_V(0);
    if constexpr (!ALIGN_EPI) { if (wr == 0) PG8_BAR; }
    PG8_BAR;
    if constexpr (Epi::AFTER_DRAIN) { E.fused(acc, cur, wr, wc, fr, fq, lds, wid, lane); S.done(cur); }
#undef PG8_SA
#undef PG8_SB
#undef PG8_STAGE
#undef PG8_LDA
#undef PG8_LDB
#undef PG8_MMA
#undef PG8_WAIT_V
#undef PG8_WAIT_L
#undef PG8_BAR
#undef PG8_SCHED
}
}

#define LAS __attribute__((address_space(3)))
typedef pg8::bf16_t bf16_t;
typedef pg8::bf16x8 bf16x8;
typedef pg8::f32x4 f32x4;
typedef pg8::u32x4 u32x4;
typedef float f32x16 __attribute__((ext_vector_type(16)));
typedef float f32x2v __attribute__((ext_vector_type(2)));
typedef unsigned u32x2 __attribute__((ext_vector_type(2)));
typedef short s16x4 __attribute__((ext_vector_type(4)));

constexpr int D = 1024, SEQ = 8192, MP = 16384, MS = 1024, M = MP + MS, NL = 2, DECB = 128, DECT = 8;
constexpr int NIN = 9216, FF = 4096, NBROW = 130, MODLD = 12288;
constexpr float EPS = 1e-6f;
constexpr int NWAVES = 8, NTHR = 512;
constexpr int LDS_BYTES = 147456;

constexpr size_t MiB = 1u << 20;
constexpr size_t WS_WIN = 1 * MiB, WS_WAO = 19 * MiB, WS_WA = 21 * MiB, WS_WB = 22 * MiB, WS_WC = 23 * MiB, WS_WO = 24 * MiB, WS_WSP = 26 * MiB;
constexpr size_t WS_MOD = 27 * MiB, WS_H = 39 * MiB, WS_G = 73 * MiB, WS_R1 = 209 * MiB;
constexpr size_t WS_Q = WS_R1, WS_KV = WS_Q + 34 * MiB, WS_GLU = WS_KV + 17 * MiB, WS_CGH = WS_GLU + 17 * MiB, WS_VV = WS_CGH + 17 * MiB, WS_BG = WS_VV + 17 * MiB, WS_U = WS_BG + 17 * MiB;
constexpr size_t WS_END = WS_U + 17 * MiB;
constexpr size_t WS_WADA = WS_G, WS_CS = WS_R1, WS_AACT = WS_H, WS_MG = WS_KV, WS_WUP = WS_CGH, WS_WDN = WS_CGH + 8 * MiB;

constexpr size_t O_PA = 17825792, O_SA = 17887232, O_PB = 21819392, O_SB = 21823488, O_PK = 22085632, O_SK = 22216704, O_PV = 30605312, O_SV = 30736384, O_SG = 39124992;

__device__ __forceinline__ unsigned cvtpk(float lo, float hi) { return pg8::cvt_pk_bf16(lo, hi); }
__device__ __forceinline__ float bflo(unsigned w) { return __uint_as_float(w << 16); }
__device__ __forceinline__ float bfhi(unsigned w) { return __uint_as_float(w & 0xffff0000u); }
__device__ __forceinline__ float bf2f(bf16_t h) { return __uint_as_float((unsigned)h << 16); }
__device__ __forceinline__ bf16_t f2bf(float f) { return (bf16_t)(cvtpk(f, 0.f) & 0xffffu); }
__device__ __forceinline__ float sigm(float x) { return __builtin_amdgcn_rcpf(1.f + __builtin_amdgcn_exp2f(-1.4426950408889634f * x)); }
__device__ __forceinline__ float gelu_t(float x) { const float u = 1.5957691216057308f * (x + 0.044715f * x * x * x); return x * sigm(u); }
__device__ __forceinline__ float wave_sum(float v) {
#pragma unroll
    for (int o = 1; o < 64; o <<= 1) v += __shfl_xor(v, o);
    return v;
}
__device__ __forceinline__ int bidx(int r) { return r < MP ? (r >> 13) : 2 + ((r - MP) >> 3); }
__device__ __forceinline__ int crow(int r, int hi) { return (r & 3) + 8 * (r >> 2) + 4 * hi; }
__device__ __forceinline__ void store8(bf16_t* p, f32x4 a, f32x4 b) {
    u32x4 w; w.x = cvtpk(a[0], a[1]); w.y = cvtpk(a[2], a[3]); w.z = cvtpk(b[0], b[1]); w.w = cvtpk(b[2], b[3]); *(u32x4*)p = w;
}

namespace epi {
using namespace pg8;
struct EpiIn {
    static constexpr bool PERM = true, AFTER_DRAIN = false;
    bf16_t *Q, *KV, *GLU, *BG, *CGH, *U, *VV, *G;
    __device__ __forceinline__ void operator()(const f32x4 (&acc)[2][2][4][2], const Unit& u, int wr, int wc, int fr, int fq) const {
        const int pn = u.pn;
        bf16_t* dst; int ld, c0, act = 0, pair = 0;
        if (pn < 4) { dst = Q; ld = 1024; c0 = 256 * pn; }
        else if (pn < 6) { dst = KV; ld = 512; c0 = 256 * (pn - 4); }
        else if (pn < 10) { dst = GLU; ld = 512; c0 = 128 * (pn - 6); pair = 1; }
        else if (pn < 12) { dst = BG; ld = 512; c0 = 256 * (pn - 10); }
        else if (pn < 16) { dst = CGH; ld = 512; c0 = 128 * (pn - 12); pair = 2; }
        else if (pn < 18) { dst = U; ld = 512; c0 = 256 * (pn - 16); act = 2; }
        else if (pn < 20) { dst = VV; ld = 512; c0 = 256 * (pn - 18); act = 2; }
        else { dst = G; ld = 4096; c0 = 256 * (pn - 20); act = 1; }
        const int row0 = u.pm * BM + wr * 64 + fr, col0 = c0 + wc * 32 + 8 * fq;
#pragma unroll
        for (int ai = 0; ai < 2; ++ai)
#pragma unroll
            for (int m = 0; m < 4; ++m) {
                bf16_t* rowp = dst + (size_t)(row0 + ai * HALF + m * 16) * ld + col0;
                if (pair) {
                    f32x4 a0 = acc[ai][0][m][0], a1 = acc[ai][0][m][1], g0 = acc[ai][1][m][0], g1 = acc[ai][1][m][1];
                    if (pair == 1) {
#pragma unroll
                        for (int i = 0; i < 4; ++i) { g0[i] = sigm(g0[i]); g1[i] = sigm(g1[i]); }
                    }
                    store8(rowp, a0 * g0, a1 * g1);
                } else {
#pragma unroll
                    for (int bj = 0; bj < 2; ++bj) {
                        f32x4 v0 = acc[ai][bj][m][0], v1 = acc[ai][bj][m][1];
                        if (act == 1) {
#pragma unroll
                            for (int i = 0; i < 4; ++i) { v0[i] = sigm(v0[i]); v1[i] = sigm(v1[i]); }
                        } else if (act == 2) {
#pragma unroll
                            for (int i = 0; i < 4; ++i) { v0[i] = gelu_t(v0[i]); v1[i] = gelu_t(v1[i]); }
                        }
                        store8(rowp + bj * HALF, v0, v1);
                    }
                }
            }
    }
};
struct EpiUp {
    static constexpr bool PERM = true, AFTER_DRAIN = false;
    bf16_t* O; int ld;
    __device__ __forceinline__ void operator()(const f32x4 (&acc)[2][2][4][2], const Unit& u, int wr, int wc, int fr, int fq) const {
        const int row0 = u.pm * BM + wr * 64 + fr, col0 = u.pn * BM + wc * 32 + 8 * fq;
#pragma unroll
        for (int ai = 0; ai < 2; ++ai)
#pragma unroll
            for (int m = 0; m < 4; ++m) {
                bf16_t* rowp = O + (size_t)(row0 + ai * HALF + m * 16) * ld + col0;
#pragma unroll
                for (int bj = 0; bj < 2; ++bj) {
                    f32x4 v0 = acc[ai][bj][m][0], v1 = acc[ai][bj][m][1];
#pragma unroll
                    for (int i = 0; i < 4; ++i) { const float a = fmaxf(v0[i], 0.f), b = fmaxf(v1[i], 0.f); v0[i] = a * a; v1[i] = b * b; }
                    store8(rowp + bj * HALF, v0, v1);
                }
            }
    }
};
struct EpiBranch {
    static constexpr bool PERM = true, AFTER_DRAIN = false;
    bf16_t* MG; const bf16_t* Gt; int first;
    __device__ __forceinline__ void operator()(const f32x4 (&acc)[2][2][4][2], const Unit& u, int wr, int wc, int fr, int fq) const {
        const int row0 = u.pm * BM + wr * 64 + fr, col0 = u.pn * BM + wc * 32 + 8 * fq;
#pragma unroll
        for (int ai = 0; ai < 2; ++ai)
#pragma unroll
            for (int m = 0; m < 4; ++m) {
                const size_t r = (size_t)(row0 + ai * HALF + m * 16);
#pragma unroll
                for (int bj = 0; bj < 2; ++bj) {
                    const int c = col0 + bj * HALF;
                    const u32x4 gw = *(const u32x4*)(Gt + r * 4096 + c);
                    f32x4 v0 = acc[ai][bj][m][0], v1 = acc[ai][bj][m][1];
                    v0[0] *= bflo(gw.x); v0[1] *= bfhi(gw.x); v0[2] *= bflo(gw.y); v0[3] *= bfhi(gw.y);
                    v1[0] *= bflo(gw.z); v1[1] *= bfhi(gw.z); v1[2] *= bflo(gw.w); v1[3] *= bfhi(gw.w);
                    bf16_t* mp = MG + r * 1024 + c;
                    if (!first) {
                        const u32x4 mw = *(const u32x4*)mp;
                        v0[0] += bflo(mw.x); v0[1] += bfhi(mw.x); v0[2] += bflo(mw.y); v0[3] += bfhi(mw.y);
                        v1[0] += bflo(mw.z); v1[1] += bfhi(mw.z); v1[2] += bflo(mw.w); v1[3] += bfhi(mw.w);
                    }
                    store8(mp, v0, v1);
                }
            }
    }
};
struct EpiRes {
    static constexpr bool PERM = false, AFTER_DRAIN = false;
    float* X; const float* gate;
    __device__ __forceinline__ void operator()(const f32x4 (&acc)[2][2][4][2], const Unit& u, int wr, int wc, int fr, int fq) const {
        const int row0 = u.pm * BM + wr * 64 + fr, col0 = u.pn * BM + wc * 32 + 4 * fq;
#pragma unroll
        for (int ai = 0; ai < 2; ++ai)
#pragma unroll
            for (int m = 0; m < 4; ++m) {
                const int r = row0 + ai * HALF + m * 16;
                const float* gp = gate + (size_t)bidx(r) * MODLD + col0;
                float* xp = X + (size_t)r * 1024 + col0;
#pragma unroll
                for (int bj = 0; bj < 2; ++bj)
#pragma unroll
                    for (int n = 0; n < 2; ++n) {
                        const f32x4 g = *(const f32x4*)(gp + bj * HALF + n * 16);
                        f32x4 x = *(const f32x4*)(xp + bj * HALF + n * 16);
                        x += g * acc[ai][bj][m][n];
                        *(f32x4*)(xp + bj * HALF + n * 16) = x;
                    }
            }
    }
};
struct EpiMod {
    static constexpr bool PERM = false, AFTER_DRAIN = false;
    float* O; const float* bias;
    __device__ __forceinline__ void operator()(const f32x4 (&acc)[2][2][4][2], const Unit& u, int wr, int wc, int fr, int fq) const {
        const int row0 = u.pm * BM + wr * 64 + fr, col0 = u.pn * BM + wc * 32 + 4 * fq;
#pragma unroll
        for (int ai = 0; ai < 2; ++ai)
#pragma unroll
            for (int m = 0; m < 4; ++m) {
                const int r = row0 + ai * HALF + m * 16;
                if (r < NBROW) {
#pragma unroll
                    for (int bj = 0; bj < 2; ++bj)
#pragma unroll
                        for (int n = 0; n < 2; ++n) {
                            const int c = col0 + bj * HALF + n * 16;
                            *(f32x4*)(O + (size_t)r * MODLD + c) = acc[ai][bj][m][n] + *(const f32x4*)(bias + c);
                        }
                }
            }
    }
};
}

struct Args {
    const float* in[32]; float* out; unsigned char* ws; int ph_lo, ph_hi;
};

struct Ctx { int tid, lane, wave, gw, NGW, bid, G; };
__device__ __forceinline__ Ctx make_ctx() {
    int tid = threadIdx.x; asm volatile("" : "+v"(tid));
    int bid = blockIdx.x; asm volatile("" : "+s"(bid));
    Ctx c; c.tid = tid; c.lane = tid & 63; c.wave = __builtin_amdgcn_readfirstlane(tid >> 6); c.bid = bid; c.G = gridDim.x;
    c.gw = bid * NWAVES + c.wave; c.NGW = c.G * NWAVES; return c;
}

__device__ __forceinline__ int perm_in(int s) {
    if (s >= 1536 && s < 2560) { const int o = s - 1536, bj = o >> 9, r = o & 511; return 1536 + ((r >> 7) << 8) + (bj << 7) + (r & 127); }
    if (s >= 3072 && s < 4096) { const int o = s - 3072, bj = o >> 9, r = o & 511; return 3072 + ((r >> 7) << 8) + (bj << 7) + (r & 127); }
    return s;
}
__device__ __forceinline__ void transpose_job(const float* W, int K, int N, bf16_t* WT, int row_off, int mode, LAS float* scr, const Ctx& c) {
    const int nblk = N / 32, nitems = (K / 64) * nblk, lane = c.lane;
    for (int it = c.gw; it < nitems; it += c.NGW) {
        const int kb = it / nblk, nb = it % nblk, k0 = 64 * kb, n0 = 32 * nb;
        const int d0 = row_off + (mode == 1 ? perm_in(n0) : n0);
#pragma unroll 8
        for (int i = 0; i < 32; ++i) { const int kk = 2 * i + (lane >> 5); scr[kk * 33 + (lane & 31)] = W[(size_t)(k0 + kk) * N + n0 + (lane & 31)]; }
        asm volatile("s_waitcnt lgkmcnt(0)" ::: "memory");
        const int ch = lane & 7;
#pragma unroll
        for (int j = 0; j < 4; ++j) {
            const int n = (lane >> 3) + 8 * j; const LAS float* s = scr + (8 * ch) * 33 + n;
            u32x4 o; o.x = cvtpk(s[0 * 33], s[1 * 33]); o.y = cvtpk(s[2 * 33], s[3 * 33]); o.z = cvtpk(s[4 * 33], s[5 * 33]); o.w = cvtpk(s[6 * 33], s[7 * 33]);
            *(u32x4*)(WT + (size_t)(d0 + n) * K + k0 + 8 * ch) = o;
        }
        asm volatile("s_waitcnt lgkmcnt(0)" ::: "memory");
    }
}

__device__ __forceinline__ void adaln_rows(const float* xp, const float* xs, float* Xcopy, bf16_t* Hout, const float* g, const float* shift, const float* scale, const Ctx& c) {
    for (int row = c.gw; row < M; row += c.NGW) {
        const float* src = row < MP ? xp + (size_t)row * D : xs + (size_t)(row - MP) * D;
        const int b = bidx(row);
        const float* sh = shift + (size_t)b * MODLD; const float* sc = scale + (size_t)b * MODLD;
        f32x4 v[4]; float ss = 0.f;
#pragma unroll
        for (int j = 0; j < 4; ++j) { v[j] = *(const f32x4*)(src + 4 * (c.lane + 64 * j)); ss += (v[j][0] * v[j][0] + v[j][1] * v[j][1]) + (v[j][2] * v[j][2] + v[j][3] * v[j][3]); }
        const float rstd = 1.0f / sqrtf(wave_sum(ss) * (1.f / D) + EPS);
#pragma unroll
        for (int j = 0; j < 4; ++j) {
            const int col = 4 * (c.lane + 64 * j);
            if (Xcopy) *(f32x4*)(Xcopy + (size_t)row * D + col) = v[j];
            const f32x4 gg = *(const f32x4*)(g + col), s1 = *(const f32x4*)(sc + col), s0 = *(const f32x4*)(sh + col);
            f32x4 o = v[j] * rstd * gg * (s1 + 1.0f) + s0;
            u32x2 w; w.x = cvtpk(o[0], o[1]); w.y = cvtpk(o[2], o[3]);
            *(u32x2*)(Hout + (size_t)row * D + col) = w;
        }
    }
}

struct C0P {
    bf16_t *Q, *KV, *VV; const bf16_t *GLU, *CGH;
    const float *qg, *kg, *lncg, *lncb, *cache_k, *cache_v, *state_a; float* out; int l;
};
__device__ __forceinline__ void phase_c0(const C0P& p, const Ctx& c) {
    const int lane = c.lane, hl = lane >> 4, e = lane & 15;
    const double invf[8] = {1.0, 0.19392274474868576, 0.03760603093086393, 0.007292664737217109, 0.001414213562373095, 0.0002742481756762073, 5.318295896944988e-05, 1.031338537721246e-05};
    for (int row = c.gw; row < M; row += c.NGW) {
        const int pos = row < MP ? (row & (SEQ - 1)) : MP + ((row - MP) & 7);
        float cs[4], sn[4];
#pragma unroll
        for (int i = 0; i < 4; ++i) {
            const int fi = 4 * (e & 1) + i;
            double iv = invf[0];
#pragma unroll
            for (int k = 1; k < 8; ++k) iv = (fi == k) ? invf[k] : iv;
            const double rev = (double)pos * iv * 0.15915494309189535;
            const float fr = (float)(rev - __builtin_rint(rev));
            cs[i] = __builtin_amdgcn_cosf(fr); sn[i] = __builtin_amdgcn_sinf(fr);
        }
        long kvo = -1;
        if (row < MP) { const int t = row & (SEQ - 1); if (t >= SEQ - 128) kvo = ((long)(p.l * 2 + (row >> 13)) * 128 + (t - (SEQ - 128))) * 256; }
        else { const int bs = (row - MP) >> 3, t = (row - MP) & 7; kvo = ((long)(p.l * DECB + bs) * 128 + 120 + t) * 256; }
        const size_t ok_base = row < MP ? O_PK : O_SK, ov_base = row < MP ? O_PV : O_SV;
#pragma unroll 1
        for (int g5 = 0; g5 < 6; ++g5) {
            bf16_t* ptr = g5 < 4 ? p.Q + (size_t)row * 1024 + (4 * g5 + hl) * 64 + 4 * e : p.KV + (size_t)row * 512 + (g5 - 4) * 256 + hl * 64 + 4 * e;
            const u32x2 w = *(const u32x2*)ptr;
            f32x4 x = {bflo(w.x), bfhi(w.x), bflo(w.y), bfhi(w.y)};
            if (g5 < 5) {
                float ss = (x[0] * x[0] + x[1] * x[1]) + (x[2] * x[2] + x[3] * x[3]);
                ss += __shfl_xor(ss, 1); ss += __shfl_xor(ss, 2); ss += __shfl_xor(ss, 4); ss += __shfl_xor(ss, 8);
                const float rstd = 1.0f / sqrtf(ss * (1.f / 64.f) + EPS);
                const f32x4 gg = *(const f32x4*)((g5 < 4 ? p.qg : p.kg) + 4 * e);
                x = x * rstd * gg;
                f32x4 pr;
#pragma unroll
                for (int i = 0; i < 4; ++i) pr[i] = __shfl_xor(x[i], 2);
                if (e < 4) {
#pragma unroll
                    for (int i = 0; i < 4; ++i) x[i] = (e < 2) ? (x[i] * cs[i] - pr[i] * sn[i]) : (x[i] * cs[i] + pr[i] * sn[i]);
                }
                u32x2 o; o.x = cvtpk(x[0], x[1]); o.y = cvtpk(x[2], x[3]);
                *(u32x2*)ptr = o;
            }
            if (g5 >= 4 && kvo >= 0) *(f32x4*)(p.out + (g5 == 4 ? ok_base : ov_base) + kvo + hl * 64 + 4 * e) = x;
        }
        {
            bf16_t* vp = p.VV + (size_t)row * 512 + 8 * lane;
            const u32x4 w = *(const u32x4*)vp;
            float v[8] = {bflo(w.x), bfhi(w.x), bflo(w.y), bfhi(w.y), bflo(w.z), bfhi(w.z), bflo(w.w), bfhi(w.w)};
            float s = 0.f;
#pragma unroll
            for (int i = 0; i < 8; ++i) s += v[i];
            const float mean = wave_sum(s) * (1.f / 512.f);
            float q = 0.f;
#pragma unroll
            for (int i = 0; i < 8; ++i) { v[i] -= mean; q += v[i] * v[i]; }
            const float rstd = 1.0f / sqrtf(wave_sum(q) * (1.f / 512.f) + EPS);
            const f32x4 g0 = *(const f32x4*)(p.lncg + 8 * lane), g1 = *(const f32x4*)(p.lncg + 8 * lane + 4);
            const f32x4 b0 = *(const f32x4*)(p.lncb + 8 * lane), b1 = *(const f32x4*)(p.lncb + 8 * lane + 4);
            f32x4 o0, o1;
#pragma unroll
            for (int i = 0; i < 4; ++i) { o0[i] = v[i] * rstd * g0[i] + b0[i]; o1[i] = v[4 + i] * rstd * g1[i] + b1[i]; }
            store8(vp, o0, o1);
            if (row >= MP) { float* og = p.out + O_SG + ((size_t)p.l * MS + (row - MP)) * 512 + 8 * lane; *(f32x4*)og = o0; *(f32x4*)(og + 4) = o1; }
        }
    }
    const long gt = (long)c.gw * 64 + c.lane, NT = (long)c.NGW * 64;
    for (long i = gt; i < (long)DECB * 7680; i += NT) {
        const long b = i / 7680, o = i % 7680;
        const size_t src = ((size_t)(p.l * DECB + b) * 128 + 8) * 256 + o * 4, dst = ((size_t)(p.l * DECB + b) * 128) * 256 + o * 4;
        *(f32x4*)(p.out + O_SK + dst) = *(const f32x4*)(p.cache_k + src);
        *(f32x4*)(p.out + O_SV + dst) = *(const f32x4*)(p.cache_v + src);
    }
    for (long i = gt; i < 2 * 30 * 128; i += NT) {
        const int b = (int)(i / (30 * 128)), r = (int)(i % (30 * 128)), j = r >> 7, c4 = (r & 127) * 4;
        const u32x2 w = *(const u32x2*)(p.GLU + ((size_t)b * SEQ + SEQ - 30 + j) * 512 + c4);
        *(f32x4*)(p.out + O_PA + (((size_t)p.l * 2 + b) * 30 + j) * 512 + c4) = (f32x4){bflo(w.x), bfhi(w.x), bflo(w.y), bfhi(w.y)};
    }
    for (long i = gt; i < (long)DECB * 30 * 128; i += NT) {
        const int b = (int)(i / (30 * 128)), r = (int)(i % (30 * 128)), j = r >> 7, c4 = (r & 127) * 4;
        f32x4 v;
        if (j < 22) v = *(const f32x4*)(p.state_a + (((size_t)p.l * DECB + b) * 30 + j + 8) * 512 + c4);
        else { const u32x2 w = *(const u32x2*)(p.GLU + ((size_t)MP + b * 8 + (j - 22)) * 512 + c4); v = (f32x4){bflo(w.x), bfhi(w.x), bflo(w.y), bfhi(w.y)}; }
        *(f32x4*)(p.out + O_SA + (((size_t)p.l * DECB + b) * 30 + j) * 512 + c4) = v;
    }
    for (long i = gt; i < 2 * 2 * 128; i += NT) {
        const int b = (int)(i / 256), r = (int)(i % 256), j = r >> 7, c4 = (r & 127) * 4;
        const u32x2 w = *(const u32x2*)(p.CGH + ((size_t)b * SEQ + SEQ - 2 + j) * 512 + c4);
        *(f32x4*)(p.out + O_PB + (((size_t)p.l * 2 + b) * 2 + j) * 512 + c4) = (f32x4){bflo(w.x), bfhi(w.x), bflo(w.y), bfhi(w.y)};
    }
    for (long i = gt; i < (long)DECB * 2 * 128; i += NT) {
        const int b = (int)(i / 256), r = (int)(i % 256), j = r >> 7, c4 = (r & 127) * 4;
        const u32x2 w = *(const u32x2*)(p.CGH + ((size_t)MP + b * 8 + 6 + j) * 512 + c4);
        *(f32x4*)(p.out + O_SB + (((size_t)p.l * DECB + b) * 2 + j) * 512 + c4) = (f32x4){bflo(w.x), bfhi(w.x), bflo(w.y), bfhi(w.y)};
    }
}

constexpr int KS_LD = 72, VT_LD = 264;
constexpr int KS_BYTES = 256 * KS_LD * 2, VT_BYTES = 64 * VT_LD * 2;

template <bool SAMPLE>
__device__ __forceinline__ void attn_wave(const LAS bf16_t* Ks, const LAS bf16_t* Vt, int kbase, int kmin, bf16_t* Qb  ,
                                          const float* sinks  , int lane) {
    const int q = lane & 31, hi = lane >> 5;
    auto rowoff = [&](int r) -> size_t { return SAMPLE ? (size_t)(r & 7) * 1024 + (r >> 3) * 64 : (size_t)r * 1024; };
    const bf16_t* Qp = Qb + rowoff(q);
    const int lo = SAMPLE ? (q & 7) : q;
    const float sink = (SAMPLE ? sinks[q >> 3] : sinks[0]) * 1.4426950408889634f;
    bf16x8 qf[4];
#pragma unroll
    for (int d0 = 0; d0 < 4; ++d0) qf[d0] = *(const bf16x8*)(Qp + 16 * d0 + 8 * hi);
    f32x16 s[5];
#pragma unroll
    for (int t = 0; t < 5; ++t) {
        s[t] = (f32x16){0.f, 0.f, 0.f, 0.f, 0.f, 0.f, 0.f, 0.f, 0.f, 0.f, 0.f, 0.f, 0.f, 0.f, 0.f, 0.f};
        const LAS bf16_t* kp = Ks + (kbase + 32 * t + q) * KS_LD + 8 * hi;
#pragma unroll
        for (int d0 = 0; d0 < 4; ++d0) { const bf16x8 kf = *(const LAS bf16x8*)(kp + 16 * d0); s[t] = __builtin_amdgcn_mfma_f32_32x32x16_bf16(kf, qf[d0], s[t], 0, 0, 0); }
        asm volatile("" ::: "memory");
    }
    const float sc = 0.125f * 1.4426950408889634f;
    float mx = sink;
#pragma unroll
    for (int t = 0; t < 5; ++t)
#pragma unroll
        for (int r = 0; r < 16; ++r) {
            const int kl = 32 * t + crow(r, hi);
            const bool vis = (kl >= lo) && (kl <= lo + 128) && (kbase + kl >= kmin);
            const float v = vis ? s[t][r] * sc : -1e30f;
            s[t][r] = v; mx = fmaxf(mx, v);
        }
    mx = fmaxf(mx, __shfl_xor(mx, 32));
    float sum = 0.f;
#pragma unroll
    for (int t = 0; t < 5; ++t)
#pragma unroll
        for (int r = 0; r < 16; ++r) { const float pv = __builtin_amdgcn_exp2f(s[t][r] - mx); s[t][r] = pv; sum += pv; }
    sum += __shfl_xor(sum, 32);
    sum += __builtin_amdgcn_exp2f(sink - mx);
    const float inv = 1.0f / sum;
    f32x16 o[2];
    o[0] = (f32x16){0.f, 0.f, 0.f, 0.f, 0.f, 0.f, 0.f, 0.f, 0.f, 0.f, 0.f, 0.f, 0.f, 0.f, 0.f, 0.f}; o[1] = o[0];
#pragma unroll
    for (int t = 0; t < 5; ++t)
#pragma unroll
        for (int cc = 0; cc < 2; ++cc) {
            u32x4 pw; pw.x = cvtpk(s[t][8 * cc + 0], s[t][8 * cc + 1]); pw.y = cvtpk(s[t][8 * cc + 2], s[t][8 * cc + 3]); pw.z = cvtpk(s[t][8 * cc + 4], s[t][8 * cc + 5]); pw.w = cvtpk(s[t][8 * cc + 6], s[t][8 * cc + 7]);
            const bf16x8 pa = __builtin_bit_cast(bf16x8, pw);
#pragma unroll
            for (int dt = 0; dt < 2; ++dt) {
                const LAS bf16_t* vp = Vt + (32 * dt + q) * VT_LD + kbase + 32 * t + 16 * cc + 4 * hi;
                const s16x4 v0 = *(const LAS s16x4*)vp, v1 = *(const LAS s16x4*)(vp + 8);
                const bf16x8 vb = (bf16x8){v0[0], v0[1], v0[2], v0[3], v1[0], v1[1], v1[2], v1[3]};
                o[dt] = __builtin_amdgcn_mfma_f32_32x32x16_bf16(pa, vb, o[dt], 0, 0, 0);
            }
            asm volatile("" ::: "memory");
        }
#pragma unroll
    for (int r = 0; r < 16; ++r) {
        const int qr = crow(r, hi);
        const float iv = __shfl(inv, qr);
        bf16_t* op = Qb + rowoff(qr) + q;
        op[0] = f2bf(o[0][r] * iv); op[32] = f2bf(o[1][r] * iv);
    }
}

struct C1P {
    bf16_t *Q, *BG, *U, *AACT; const bf16_t *KV, *GLU, *CGH, *VV, *WSP;
    const float *sinks, *cache_k, *cache_v, *state_a, *state_b, *conv_a_w, *conv_a_b, *ln_a_g, *ln_a_b, *conv_b_w, *w_sp, *b_sp; int l;
};

__device__ __forceinline__ void vt_scatter(LAS bf16_t* Vt, int ld, int d0, int row, u32x4 vv) {
    Vt[(d0 + 0) * ld + row] = (bf16_t)(vv.x & 0xffffu); Vt[(d0 + 1) * ld + row] = (bf16_t)(vv.x >> 16);
    Vt[(d0 + 2) * ld + row] = (bf16_t)(vv.y & 0xffffu); Vt[(d0 + 3) * ld + row] = (bf16_t)(vv.y >> 16);
    Vt[(d0 + 4) * ld + row] = (bf16_t)(vv.z & 0xffffu); Vt[(d0 + 5) * ld + row] = (bf16_t)(vv.z >> 16);
    Vt[(d0 + 6) * ld + row] = (bf16_t)(vv.w & 0xffffu); Vt[(d0 + 7) * ld + row] = (bf16_t)(vv.w >> 16);
}

__device__ __forceinline__ void phase_attn(const C1P& p, LAS unsigned char* lds, const Ctx& c) {
    const int tid = c.tid, wid = c.wave, lane = c.lane;
    LAS bf16_t* Ks = (LAS bf16_t*)lds; LAS bf16_t* Vt = (LAS bf16_t*)(lds + KS_BYTES);
    for (int u = c.bid; u < 2 * 4 * 64; u += c.G) {
        const int i = u & 63, kvh = (u >> 6) & 3, b = u >> 8;
#pragma unroll
        for (int it = 0; it < 4; ++it) {
            const int id = tid + 512 * it, row = id >> 3, ch = id & 7;
            const int pos = (i - 1) * 128 + row;
            u32x4 kk = {0u, 0u, 0u, 0u}, vv = {0u, 0u, 0u, 0u};
            if (pos >= 0) { const bf16_t* src = p.KV + ((size_t)b * SEQ + pos) * 512 + kvh * 64 + ch * 8; kk = *(const u32x4*)src; vv = *(const u32x4*)(src + 256); }
            *(LAS u32x4*)(Ks + row * KS_LD + ch * 8) = kk;
            vt_scatter(Vt, VT_LD, ch * 8, row, vv);
        }
        __syncthreads();
        const int head = kvh * 4 + (wid >> 1);
#pragma unroll 1
        for (int a2 = 0; a2 < 2; ++a2) {
            const int a = 2 * (wid & 1) + a2;
            attn_wave<false>(Ks, Vt, 32 * a, (i == 0) ? 128 : 0, p.Q + ((size_t)b * SEQ + i * 128 + 32 * a) * 1024 + head * 64, p.sinks + head, lane);
        }
        __syncthreads();
    }
    constexpr int REG = KS_BYTES + VT_BYTES;
    for (int u = c.bid; u < DECB * 2; u += c.G) {
        const int b = u >> 1, kp = u & 1;
#pragma unroll 1
        for (int it = 0; it < 5; ++it) {
            const int id = tid + 512 * it;
            const int sel = id / 1280, rem = id % 1280, row = rem >> 3, ch = rem & 7, kvh = 2 * kp + sel;
            LAS bf16_t* Ks2 = (LAS bf16_t*)(lds + sel * REG); LAS bf16_t* Vt2 = (LAS bf16_t*)(lds + sel * REG + KS_BYTES);
            u32x4 kk = {0u, 0u, 0u, 0u}, vv = {0u, 0u, 0u, 0u};
            if (row < 128) {
                const size_t so = (((size_t)(p.l * DECB + b) * 128 + row) * 4 + kvh) * 64 + ch * 8;
                const f32x4 k0 = *(const f32x4*)(p.cache_k + so), k1 = *(const f32x4*)(p.cache_k + so + 4), v0 = *(const f32x4*)(p.cache_v + so), v1 = *(const f32x4*)(p.cache_v + so + 4);
                kk.x = cvtpk(k0[0], k0[1]); kk.y = cvtpk(k0[2], k0[3]); kk.z = cvtpk(k1[0], k1[1]); kk.w = cvtpk(k1[2], k1[3]);
                vv.x = cvtpk(v0[0], v0[1]); vv.y = cvtpk(v0[2], v0[3]); vv.z = cvtpk(v1[0], v1[1]); vv.w = cvtpk(v1[2], v1[3]);
            } else if (row < 136) {
                const bf16_t* src = p.KV + ((size_t)MP + b * 8 + (row - 128)) * 512 + kvh * 64 + ch * 8; kk = *(const u32x4*)src; vv = *(const u32x4*)(src + 256);
            }
            *(LAS u32x4*)(Ks2 + row * KS_LD + ch * 8) = kk;
            vt_scatter(Vt2, VT_LD, ch * 8, row, vv);
        }
        __syncthreads();
        if (wid < 2) {
            const int kvh = 2 * kp + wid;
            attn_wave<true>((const LAS bf16_t*)(lds + wid * REG), (const LAS bf16_t*)(lds + wid * REG + KS_BYTES), 0, 0, p.Q + ((size_t)MP + b * 8) * 1024 + kvh * 256, p.sinks + kvh * 4, lane);
        }
        __syncthreads();
    }
}

template <int NOUT>
__device__ __forceinline__ void conv31(const f32x2v (&x)[NOUT + 30], const f32x2v (&w)[31], f32x2v bias, LAS float* dst  ) {
#pragma unroll
    for (int k = 0; k < NOUT; ++k) {
        f32x2v a = bias;
#pragma unroll
        for (int j = 0; j < 31; ++j) a += w[j] * x[k + j];
        *(LAS f32x2v*)(dst + k * 512) = a;
    }
}
__device__ __forceinline__ void phase_conva(const C1P& p, LAS unsigned char* lds, const Ctx& c) {
    const int tid = c.tid, wid = c.wave, lane = c.lane, c2 = tid & 255, h = tid >> 8;
    LAS float* buf = (LAS float*)lds;
    f32x2v w[31];
#pragma unroll
    for (int j = 0; j < 31; ++j) w[j] = *(const f32x2v*)(p.conv_a_w + ((size_t)p.l * 31 + j) * 512 + 2 * c2);
    const f32x2v bias = *(const f32x2v*)(p.conv_a_b + (size_t)p.l * 512 + 2 * c2);
    for (int ut = c.bid; ut < M / 64; ut += c.G) {
        const int R0 = 64 * ut;
        if (R0 < MP) {
#pragma unroll 1
            for (int ps = 0; ps < 2; ++ps) {
                const int tb = R0 + 32 * h + 16 * ps, ts = tb & (SEQ - 1);
                f32x2v x[46];
#pragma unroll
                for (int i = 0; i < 46; ++i) {
                    unsigned wv = 0u;
                    if (ts - 30 + i >= 0) wv = *(const unsigned*)(p.GLU + (size_t)(tb - 30 + i) * 512 + 2 * c2);
                    x[i] = (f32x2v){bflo(wv), bfhi(wv)};
                }
                conv31<16>(x, w, bias, buf + (32 * h + 16 * ps) * 512 + 2 * c2);
            }
        } else {
#pragma unroll 1
            for (int sq = 0; sq < 4; ++sq) {
                const int bs = (R0 - MP) / 8 + 4 * h + sq;
                f32x2v x[38];
#pragma unroll
                for (int i = 0; i < 30; ++i) x[i] = *(const f32x2v*)(p.state_a + (((size_t)p.l * DECB + bs) * 30 + i) * 512 + 2 * c2);
#pragma unroll
                for (int i = 0; i < 8; ++i) { const unsigned wv = *(const unsigned*)(p.GLU + ((size_t)MP + bs * 8 + i) * 512 + 2 * c2); x[30 + i] = (f32x2v){bflo(wv), bfhi(wv)}; }
                conv31<8>(x, w, bias, buf + (8 * (4 * h + sq)) * 512 + 2 * c2);
            }
        }
        __syncthreads();
        const f32x4 g0 = *(const f32x4*)(p.ln_a_g + (size_t)p.l * 512 + 8 * lane), g1 = *(const f32x4*)(p.ln_a_g + (size_t)p.l * 512 + 8 * lane + 4);
        const f32x4 b0 = *(const f32x4*)(p.ln_a_b + (size_t)p.l * 512 + 8 * lane), b1 = *(const f32x4*)(p.ln_a_b + (size_t)p.l * 512 + 8 * lane + 4);
#pragma unroll 1
        for (int k = 0; k < 8; ++k) {
            const int tok = 8 * wid + k;
            f32x4 v0 = *(const LAS f32x4*)(buf + tok * 512 + 8 * lane), v1 = *(const LAS f32x4*)(buf + tok * 512 + 8 * lane + 4);
            const float mean = wave_sum((v0[0] + v0[1]) + (v0[2] + v0[3]) + (v1[0] + v1[1]) + (v1[2] + v1[3])) * (1.f / 512.f);
            v0 -= mean; v1 -= mean;
            const float var = wave_sum((v0[0] * v0[0] + v0[1] * v0[1]) + (v0[2] * v0[2] + v0[3] * v0[3]) + (v1[0] * v1[0] + v1[1] * v1[1]) + (v1[2] * v1[2] + v1[3] * v1[3])) * (1.f / 512.f);
            const float rstd = 1.0f / sqrtf(var + EPS);
            f32x4 o0, o1;
#pragma unroll
            for (int i = 0; i < 4; ++i) { const float y0 = v0[i] * rstd * g0[i] + b0[i], y1 = v1[i] * rstd * g1[i] + b1[i]; o0[i] = y0 * sigm(y0); o1[i] = y1 * sigm(y1); }
            store8(p.AACT + (size_t)(R0 + tok) * 512 + 8 * lane, o0, o1);
        }
        __syncthreads();
    }
}

__device__ __forceinline__ void phase_convb(const C1P& p, const Ctx& c) {
    const long gt = (long)c.gw * 64 + c.lane, NT = (long)c.NGW * 64;
    for (long i = gt; i < (long)M * 64; i += NT) {
        const int row = (int)(i >> 6), c8 = (int)(i & 63) * 8;
        f32x4 w0[2], w1[2], w2[2];
#pragma unroll
        for (int hh = 0; hh < 2; ++hh) {
            w0[hh] = *(const f32x4*)(p.conv_b_w + ((size_t)p.l * 3 + 0) * 512 + c8 + 4 * hh);
            w1[hh] = *(const f32x4*)(p.conv_b_w + ((size_t)p.l * 3 + 1) * 512 + c8 + 4 * hh);
            w2[hh] = *(const f32x4*)(p.conv_b_w + ((size_t)p.l * 3 + 2) * 512 + c8 + 4 * hh);
        }
        f32x4 x0[2], x1[2], x2[2];
        auto ldb = [&](size_t r, f32x4 (&d)[2]) { const u32x4 w = *(const u32x4*)(p.CGH + r * 512 + c8); d[0] = (f32x4){bflo(w.x), bfhi(w.x), bflo(w.y), bfhi(w.y)}; d[1] = (f32x4){bflo(w.z), bfhi(w.z), bflo(w.w), bfhi(w.w)}; };
        ldb((size_t)row, x2);
        const f32x4 z4 = {0.f, 0.f, 0.f, 0.f};
        if (row < MP) {
            const int t = row & (SEQ - 1);
            if (t >= 1) ldb((size_t)row - 1, x1); else { x1[0] = z4; x1[1] = z4; }
            if (t >= 2) ldb((size_t)row - 2, x0); else { x0[0] = z4; x0[1] = z4; }
        } else {
            const int bs = (row - MP) >> 3, t = (row - MP) & 7;
            const float* st = p.state_b + ((size_t)p.l * DECB + bs) * 2 * 512 + c8;
            if (t >= 1) ldb((size_t)row - 1, x1); else { x1[0] = *(const f32x4*)(st + 512); x1[1] = *(const f32x4*)(st + 512 + 4); }
            if (t >= 2) ldb((size_t)row - 2, x0); else { x0[0] = *(const f32x4*)(st + t * 512); x0[1] = *(const f32x4*)(st + t * 512 + 4); }
        }
        bf16_t* bp = p.BG + (size_t)row * 512 + c8;
        const u32x4 bw = *(const u32x4*)bp;
        const f32x4 bg0 = {bflo(bw.x), bfhi(bw.x), bflo(bw.y), bfhi(bw.y)}, bg1 = {bflo(bw.z), bfhi(bw.z), bflo(bw.w), bfhi(bw.w)};
        const f32x4 o0 = bg0 * (w0[0] * x0[0] + w1[0] * x1[0] + w2[0] * x2[0]), o1 = bg1 * (w0[1] * x0[1] + w1[1] * x1[1] + w2[1] * x2[1]);
        store8(bp, o0, o1);
    }
}

constexpr int VVT_LD = 136;
__device__ __forceinline__ void phase_gmlp(const C1P& p, LAS unsigned char* lds, const Ctx& c) {
    const int tid = c.tid, wid = c.wave, lane = c.lane, q = lane & 31, hi = lane >> 5;
    LAS bf16_t* VVt = (LAS bf16_t*)lds;
    for (int u = c.bid; u < 128 * 2; u += c.G) {
        const int ci = u >> 1, hh = u & 1, tok0 = ci * 128;
#pragma unroll 1
        for (int it = 0; it < 8; ++it) {
            const int id = tid + 512 * it, row = id >> 5, ch = id & 31;
            const u32x4 vv = *(const u32x4*)(p.VV + (size_t)(tok0 + row) * 512 + 256 * hh + ch * 8);
            vt_scatter(VVt, VVT_LD, ch * 8, row, vv);
        }
        __syncthreads();
        const int gl = wid >> 1, dt = wid & 1, g = 4 * hh + gl;
        const bf16_t* Wg = p.WSP + ((size_t)(p.l * 8 + g) * 128) * 128;
        const float* bs = p.b_sp + (size_t)(p.l * 8 + g) * 128;
#pragma unroll 1
        for (int ti = 0; ti < 4; ++ti) {
            f32x16 acc = (f32x16){0.f, 0.f, 0.f, 0.f, 0.f, 0.f, 0.f, 0.f, 0.f, 0.f, 0.f, 0.f, 0.f, 0.f, 0.f, 0.f};
            for (int ks = 0; ks < 2 * ti + 2; ++ks) {
                const bf16x8 a = *(const bf16x8*)(Wg + (size_t)(32 * ti + q) * 128 + 16 * ks + 8 * hi);
                const bf16x8 bv = *(const LAS bf16x8*)(VVt + (gl * 64 + 32 * dt + q) * VVT_LD + 16 * ks + 8 * hi);
                acc = __builtin_amdgcn_mfma_f32_32x32x16_bf16(a, bv, acc, 0, 0, 0);
            }
#pragma unroll
            for (int r = 0; r < 16; ++r) {
                const int t = 32 * ti + crow(r, hi);
                bf16_t* up = p.U + (size_t)(tok0 + t) * 512 + g * 64 + 32 * dt + q;
                *up = f2bf(bf2f(*up) * (acc[r] + bs[t]));
            }
        }
        __syncthreads();
    }
    const long gt = (long)c.gw * 64 + c.lane, NT = (long)c.NGW * 64;
    for (long i = gt; i < (long)DECB * 512; i += NT) {
        const int b = (int)(i >> 9), ch = (int)(i & 511), g = ch >> 6;
        const float* Wg = p.w_sp + ((size_t)(p.l * 8 + g) * 128) * 128;
        const float* bs = p.b_sp + (size_t)(p.l * 8 + g) * 128;
        float vv[8];
#pragma unroll
        for (int s = 0; s < 8; ++s) vv[s] = bf2f(p.VV[((size_t)MP + b * 8 + s) * 512 + ch]);
#pragma unroll
        for (int t = 0; t < 8; ++t) {
            float z = bs[t];
#pragma unroll
            for (int s = 0; s <= t; ++s) z += Wg[t * 128 + s] * vv[s];
            bf16_t* up = p.U + ((size_t)MP + b * 8 + t) * 512 + ch;
            *up = f2bf(bf2f(*up) * z);
        }
    }
}

#ifndef KMASK
#define KMASK 0xFFFF
#endif
#define KEN(k) ((KMASK >> (k)) & 1)
enum { I_XP = 0, I_XS, I_CP, I_CS, I_STA, I_STB, I_CK, I_CV, I_WADA, I_BADA, I_N1G, I_N2G, I_WIN, I_QNG, I_KNG, I_SINK, I_WAO, I_CAW, I_CAB, I_LAG, I_LAB,
       I_WAOUT, I_CBW, I_WBOUT, I_LCG, I_LCB, I_WSP, I_BSP, I_WCOUT, I_WO, I_WUP, I_WDN };

typedef const __attribute__((address_space(4))) Args* ArgsP;
__device__ __forceinline__ ArgsP get_args() { ArgsP ap = (ArgsP)__builtin_amdgcn_kernarg_segment_ptr(); asm volatile("" : "+s"(ap)); return ap; }
#define WSB(off) ((bf16_t*)(ws + (off)))
__device__ __forceinline__ C1P make_c1p(ArgsP a, int l) {
    unsigned char* ws = a->ws;
    C1P p{WSB(WS_Q), WSB(WS_BG), WSB(WS_U), WSB(WS_AACT), WSB(WS_KV), WSB(WS_GLU), WSB(WS_CGH), WSB(WS_VV), WSB(WS_WSP), a->in[I_SINK] + l * 16, a->in[I_CK], a->in[I_CV], a->in[I_STA], a->in[I_STB],
          a->in[I_CAW], a->in[I_CAB], a->in[I_LAG], a->in[I_LAB], a->in[I_CBW], a->in[I_WSP], a->in[I_BSP], l};
    return p;
}

__global__ void __launch_bounds__(NTHR, 2) mega_fwd(Args a_unused) {
    extern __shared__ __attribute__((aligned(16))) unsigned char lds_raw[];
    LAS unsigned char* lds = (LAS unsigned char*)lds_raw;
    cg::grid_group grid = cg::this_grid();
    const int ph_lo = get_args()->ph_lo, ph_hi = get_args()->ph_hi;

    for (int ph = ph_lo; ph < ph_hi; ++ph) {
        const Ctx c = make_ctx();
        LAS float* scr = (LAS float*)(lds + c.wave * 16384);
        const int l = ph < 2 ? 0 : (ph - 2) / 9, kind = ph < 2 ? ph : 2 + (ph - 2) % 9;
        switch (kind) {
        case 0: if (KEN(0)) {
            ArgsP a = get_args(); unsigned char* ws = a->ws;
            for (int ll = 0; ll < NL; ++ll) transpose_job(a->in[I_WADA] + (size_t)ll * D * 6144, D, 6144, WSB(WS_WADA), ll * 6144, 0, scr, c);
            const long gt = (long)c.gw * 64 + c.lane, NT = (long)c.NGW * 64;
            bf16_t* CS = WSB(WS_CS); bf16_t* WSPB = WSB(WS_WSP);
            const float* cp = a->in[I_CP]; const float* csm = a->in[I_CS]; const float* wsp = a->in[I_WSP];
            for (long i = gt; i < 256 * 1024; i += NT) {
                const int r = (int)(i >> 10), col = (int)(i & 1023);
                float v = 0.f;
                if (r < 2) v = cp[r * D + col]; else if (r < NBROW) v = csm[(size_t)(r - 2) * D + col];
                CS[i] = f2bf(v * sigm(v));
            }
            for (long i = gt; i < (long)NL * 8 * 128 * 128; i += NT) {
                const int t = (int)(i >> 7) & 127, s = (int)i & 127;
                WSPB[i] = f2bf(s <= t ? wsp[i] : 0.f);
            }
        } break;
        case 1: if (KEN(1)) {
            ArgsP a = get_args(); unsigned char* ws = a->ws;
            pg8::Gemm g{WSB(WS_CS), WSB(WS_WADA), 256, MODLD, D, D, D}; pg8::StaticOrder S; S.init(256, MODLD, c.G, c.bid);
            epi::EpiMod E{(float*)(ws + WS_MOD), a->in[I_BADA]};
            pg8::gemm_phase<epi::EpiMod, pg8::StaticOrder, false, true>(lds, g, S, E, c.tid);
        } break;
        case 2: if (KEN(2)) {
            { ArgsP a = get_args(); unsigned char* ws = a->ws; transpose_job(a->in[I_WIN] + (size_t)l * D * NIN, D, NIN, WSB(WS_WIN), 0, 1, scr, c); }
            { ArgsP a = get_args(); unsigned char* ws = a->ws; transpose_job(a->in[I_WAO] + (size_t)l * D * D, D, D, WSB(WS_WAO), 0, 0, scr, c); }
            { ArgsP a = get_args(); unsigned char* ws = a->ws; transpose_job(a->in[I_WAOUT] + (size_t)l * 512 * D, 512, D, WSB(WS_WA), 0, 0, scr, c); }
            { ArgsP a = get_args(); unsigned char* ws = a->ws; transpose_job(a->in[I_WBOUT] + (size_t)l * 512 * D, 512, D, WSB(WS_WB), 0, 0, scr, c); }
            { ArgsP a = get_args(); unsigned char* ws = a->ws; transpose_job(a->in[I_WCOUT] + (size_t)l * 512 * D, 512, D, WSB(WS_WC), 0, 0, scr, c); }
            { ArgsP a = get_args(); unsigned char* ws = a->ws; transpose_job(a->in[I_WO] + (size_t)l * D * D, D, D, WSB(WS_WO), 0, 0, scr, c); }
            { ArgsP a = get_args(); unsigned char* ws = a->ws; float* X = a->out;
              const float* md = (const float*)(ws + WS_MOD) + (size_t)l * 6144;
              const float* xp = l == 0 ? a->in[I_XP] : X; const float* xs = l == 0 ? a->in[I_XS] : X + (size_t)MP * D;
              adaln_rows(xp, xs, l == 0 ? X : nullptr, WSB(WS_H), a->in[I_N1G] + l * D, md + 0 * D, md + 1 * D, c); }
        } break;
        case 3: if (KEN(3)) {
            ArgsP a = get_args(); unsigned char* ws = a->ws;
            pg8::Gemm g{WSB(WS_H), WSB(WS_WIN), M, NIN, D, D, D}; pg8::StaticOrder S; S.init(M, NIN, c.G, c.bid);
            epi::EpiIn E{WSB(WS_Q), WSB(WS_KV), WSB(WS_GLU), WSB(WS_BG), WSB(WS_CGH), WSB(WS_U), WSB(WS_VV), WSB(WS_G)};
            pg8::gemm_phase<epi::EpiIn, pg8::StaticOrder, true, true>(lds, g, S, E, c.tid);
        } break;
        case 4: if (KEN(4)) {
            ArgsP a = get_args(); unsigned char* ws = a->ws;
            C0P p{WSB(WS_Q), WSB(WS_KV), WSB(WS_VV), WSB(WS_GLU), WSB(WS_CGH), a->in[I_QNG] + l * 64, a->in[I_KNG] + l * 64, a->in[I_LCG] + l * 512, a->in[I_LCB] + l * 512, a->in[I_CK], a->in[I_CV], a->in[I_STA], a->out, l};
            phase_c0(p, c);
        } break;
        case 5: if (KEN(5)) {
#ifndef SMASK
#define SMASK 15
#endif
            if (SMASK & 1) { const Ctx c1 = make_ctx(); const C1P p = make_c1p(get_args(), l); phase_attn(p, lds, c1); }
            if (SMASK & 2) { const Ctx c1 = make_ctx(); const C1P p = make_c1p(get_args(), l); phase_conva(p, lds, c1); }
            if (SMASK & 4) { const Ctx c1 = make_ctx(); const C1P p = make_c1p(get_args(), l); phase_convb(p, c1); }
            if (SMASK & 8) { const Ctx c1 = make_ctx(); const C1P p = make_c1p(get_args(), l); phase_gmlp(p, lds, c1); }
        } break;
        case 6: if (KEN(6)) {
#pragma unroll 1
            for (int br = 0; br < 4; ++br) {
                ArgsP a = get_args(); unsigned char* ws = a->ws;
                const bf16_t* A = br == 0 ? WSB(WS_Q) : br == 1 ? WSB(WS_AACT) : br == 2 ? WSB(WS_BG) : WSB(WS_U);
                const bf16_t* Bt = br == 0 ? WSB(WS_WAO) : br == 1 ? WSB(WS_WA) : br == 2 ? WSB(WS_WB) : WSB(WS_WC);
                const int K = br == 0 ? 1024 : 512;
                pg8::Gemm g{A, Bt, M, D, K, K, K}; pg8::StaticOrder S; S.init(M, D, c.G, c.bid);
                epi::EpiBranch E{WSB(WS_MG), WSB(WS_G) + br * 1024, br == 0 ? 1 : 0};
                pg8::gemm_phase<epi::EpiBranch, pg8::StaticOrder, true, true>(lds, g, S, E, c.tid);
            }
        } break;
        case 7: case 10: if (KEN(7)) {
            ArgsP a = get_args(); unsigned char* ws = a->ws;
            const bool dn = kind == 10;
            pg8::Gemm g{dn ? WSB(WS_G) : WSB(WS_MG), dn ? WSB(WS_WDN) : WSB(WS_WO), M, D, dn ? FF : D, dn ? FF : D, dn ? FF : D}; pg8::StaticOrder S; S.init(M, D, c.G, c.bid);
            epi::EpiRes E{a->out, (const float*)(ws + WS_MOD) + (size_t)l * 6144 + (dn ? 5 : 2) * D};
            pg8::gemm_phase<epi::EpiRes, pg8::StaticOrder, true, true>(lds, g, S, E, c.tid);
        } break;
        case 8: if (KEN(8)) {
            { ArgsP a = get_args(); unsigned char* ws = a->ws; transpose_job(a->in[I_WUP] + (size_t)l * D * FF, D, FF, WSB(WS_WUP), 0, 0, scr, c); }
            { ArgsP a = get_args(); unsigned char* ws = a->ws; transpose_job(a->in[I_WDN] + (size_t)l * FF * D, FF, D, WSB(WS_WDN), 0, 0, scr, c); }
            { ArgsP a = get_args(); unsigned char* ws = a->ws; float* X = a->out;
              const float* md = (const float*)(ws + WS_MOD) + (size_t)l * 6144;
              adaln_rows(X, X + (size_t)MP * D, nullptr, WSB(WS_H), a->in[I_N2G] + l * D, md + 3 * D, md + 4 * D, c); }
        } break;
        case 9: if (KEN(9)) {
            ArgsP a = get_args(); unsigned char* ws = a->ws;
            pg8::Gemm g{WSB(WS_H), WSB(WS_WUP), M, FF, D, D, D}; pg8::StaticOrder S; S.init(M, FF, c.G, c.bid);
            epi::EpiUp E{WSB(WS_G), FF};
            pg8::gemm_phase<epi::EpiUp, pg8::StaticOrder, true, true>(lds, g, S, E, c.tid);
        } break;
        default: break;
        }
        if (ph + 1 < ph_hi) grid.sync();
    }
}

constexpr int NPHASES = 2 + 9 * NL;

extern "C" void kernel_launch(void* const* d_in, const int* in_sizes, int n_in, void* d_out, int out_size, void* d_ws, size_t ws_size, hipStream_t stream) {
    static int grid = 0;
    if (grid == 0) {
        if (n_in != 32 || ws_size < WS_END) { fprintf(stderr, "kernel_launch: unexpected n_in %d / ws_size %zu (need %zu)\n", n_in, ws_size, (size_t)WS_END); grid = -1; return; }
        int dev = 0, cus = 0, per_cu = 0;
        hipGetDevice(&dev); hipDeviceGetAttribute(&cus, hipDeviceAttributeMultiprocessorCount, dev);
        hipFuncSetAttribute((const void*)mega_fwd, hipFuncAttributeMaxDynamicSharedMemorySize, LDS_BYTES);
        hipOccupancyMaxActiveBlocksPerMultiprocessor(&per_cu, (const void*)mega_fwd, NTHR, LDS_BYTES);
        (void)hipGetLastError();
        if (per_cu < 1) per_cu = 1;
        grid = cus * per_cu;
    }
    if (grid < 0) return;
    Args a{};
    for (int i = 0; i < 32; ++i) a.in[i] = (const float*)d_in[i];
    a.out = (float*)d_out; a.ws = (unsigned char*)d_ws; a.ph_lo = 0; a.ph_hi = NPHASES;
    void* args[] = {&a};
    hipError_t e = hipLaunchCooperativeKernel((const void*)mega_fwd, dim3(grid), dim3(NTHR), args, LDS_BYTES, stream);
    if (e != hipSuccess) fprintf(stderr, "cooperative launch failed: %s (grid %d)\n", hipGetErrorString(e), grid);
}
```

```cpp
#include <hip/hip_runtime.h>
#include <hip/hip_cooperative_groups.h>
#include <cstdio>
#include <cstdint>
namespace cg = cooperative_groups;
namespace pg8 {
#define PG8_LAS __attribute__((address_space(3)))
typedef unsigned short bf16_t;
typedef short bf16x8 __attribute__((ext_vector_type(8)));
typedef float f32x4 __attribute__((ext_vector_type(4)));
typedef unsigned u32x4 __attribute__((ext_vector_type(4)));
constexpr int BM = 256, BK = 64, HALF = 128, HTB = HALF * BK * 2  , STAGE_BYTES = 8 * HTB, NXCD = 8, WGM = 8;

__host__ __device__ __forceinline__ int lds_byte(int r, int c) { const int st = (r >> 4) * 2 + (c >> 5), rr = r & 15, cc = c & 31, ob = rr * 64 + cc * 2; return st * 1024 + (ob ^ (((ob >> 9) & 1) << 5)); }
__host__ __device__ __forceinline__ void stage_rc(int b, int& R, int& C) { const int st = b / 1024, sb = b % 1024, swz = sb ^ (((sb >> 9) & 1) << 5); R = (st >> 1) * 16 + swz / 64; C = (st & 1) * 32 + (swz % 64) / 2; }
__host__ __device__ __forceinline__ int perm32(int rho) { const int n = rho >> 4, i = rho & 15; return 8 * (i >> 2) + 4 * n + (i & 3); }

struct Unit { int pm, pn, aux; };
struct Gemm { const bf16_t* A; const bf16_t* Bt; int M, N, K, lda, ldb; };

struct StaticOrder {
    int nM, nN, nwg, G, c;
    __host__ __device__ void init(int M, int N, int G_, int c_) { nM = M / BM; nN = N / BM; nwg = nM * nN; G = G_; c = c_; }
    __host__ __device__ bool next(int i, Unit& u) const {
        const long L = (long)i * G + c; if (L >= nwg) return false;
        int wgid = (int)L; { const int q = nwg / NXCD, r = nwg % NXCD, xcd = wgid % NXCD, off = wgid / NXCD; wgid = (xcd < r ? xcd * (q + 1) : r * (q + 1) + (xcd - r) * q) + off; }
        const int nig = WGM * nN, gid = wgid / nig, fm = gid * WGM, gsz = (nM - fm) < WGM ? (nM - fm) : WGM;
        u.pm = fm + ((wgid % nig) % gsz); u.pn = (wgid % nig) / gsz; u.aux = 0; return true;
    }
    template <class G_> __device__ __forceinline__ const bf16_t* opA(const Unit&, const G_& g) const { return g.A; }
    template <class G_> __device__ __forceinline__ const bf16_t* opB(const Unit&, const G_& g) const { return g.Bt; }
    __device__ __forceinline__ void a_ready(const Unit&) const {}
    __device__ __forceinline__ void done(const Unit&) const {}
};
__device__ __forceinline__ unsigned cvt_pk_bf16(float lo, float hi) { unsigned r; asm volatile("v_cvt_pk_bf16_f32 %0, %1, %2" : "=v"(r) : "v"(lo), "v"(hi)); return r; }
typedef float f32x2 __attribute__((ext_vector_type(2)));
template <class Epi, class Sched, bool ALIGN_EPI = false, bool SP2 = false>
__device__ __forceinline__ void gemm_phase(PG8_LAS unsigned char* lds, const Gemm g, const Sched& S, const Epi& E, const int tid) {
    const int wid = __builtin_amdgcn_readfirstlane(tid >> 6), lane = tid & 63, wr = wid >> 2, wc = wid & 3, fr = lane & 15, fq = lane >> 4;
    const int K = g.K, nt = K / BK;
    unsigned voffA[2], voffB[2];
#pragma unroll
    for (int i = 0; i < 2; ++i) { int R, C; stage_rc(tid * 16 + i * 8192, R, C); const int Rb = Epi::PERM ? ((R & ~31) + perm32(R & 31)) : R;
        voffA[i] = (unsigned)(R * g.lda + C) * 2u; voffB[i] = (unsigned)(Rb * g.ldb + C) * 2u; }
    const size_t kstep = (size_t)(BK * 2);
    const size_t hstepA = (size_t)HALF * g.lda * 2, hstepB = (size_t)HALF * g.ldb * 2;
    const size_t tstepA = 2 * hstepA, tstepB = 2 * hstepB;
    const unsigned ldsw = (unsigned)wid * 1024u;
    const int aoff = lds_byte(wr * 64 + fr, fq * 8), boff = lds_byte(wc * 32 + fr, fq * 8);
#define PG8_SA(b, h) (((b) * 2 + (h)) * HTB)
#define PG8_SB(b, h) ((4 + (b) * 2 + (h)) * HTB)
#define PG8_STAGE(bufoff, gbase, voff) do { _Pragma("unroll") for (int _i = 0; _i < 2; ++_i) \
        __builtin_amdgcn_global_load_lds((const unsigned*)((const char*)(gbase) + (voff)[_i]), (PG8_LAS unsigned*)(lds + (bufoff) + ldsw + _i * 8192), 16, 0, 0); } while (0)
#define PG8_LDA(dst, b, h) do { _Pragma("unroll") for (int m = 0; m < 4; ++m) _Pragma("unroll") for (int k = 0; k < 2; ++k) dst[m][k] = *(const PG8_LAS bf16x8*)(lds + PG8_SA(b, h) + aoff + m * 2048 + k * 1024); } while (0)
#define PG8_LDB(dst, b, h) do { _Pragma("unroll") for (int n = 0; n < 2; ++n) _Pragma("unroll") for (int k = 0; k < 2; ++k) dst[n][k] = *(const PG8_LAS bf16x8*)(lds + PG8_SB(b, h) + boff + n * 2048 + k * 1024); } while (0)
#define PG8_MMA(ai, bj, At, Bt) do { __builtin_amdgcn_s_setprio(1); _Pragma("unroll") for (int m = 0; m < 4; ++m) _Pragma("unroll") for (int n = 0; n < 2; ++n) _Pragma("unroll") for (int k = 0; k < 2; ++k) \
        acc[ai][bj][m][n] = __builtin_amdgcn_mfma_f32_16x16x32_bf16(Bt[n][k], At[m][k], acc[ai][bj][m][n], 0, 0, 0); __builtin_amdgcn_s_setprio(0); } while (0)
#define PG8_WAIT_V(n) asm volatile("s_waitcnt vmcnt(" #n ")" ::: "memory")
#define PG8_WAIT_L(n) asm volatile("s_waitcnt lgkmcnt(" #n ")" ::: "memory")
#define PG8_BAR __builtin_amdgcn_s_barrier()
#define PG8_SCHED __builtin_amdgcn_sched_barrier(0)
    Unit cur, nxt; int ui = 0;
    if (!S.next(0, cur)) return;
    f32x4 acc[2][2][4][2];
#pragma unroll
    for (int a = 0; a < 2; ++a)
#pragma unroll
        for (int b = 0; b < 2; ++b)
#pragma unroll
            for (int m = 0; m < 4; ++m)
#pragma unroll
                for (int n = 0; n < 2; ++n) acc[a][b][m][n] = (f32x4){0.f, 0.f, 0.f, 0.f};
    bf16x8 At[4][2], B0[2][2], B1[2][2];
    const char* cA = (const char*)S.opA(cur, g) + (size_t)cur.pm * tstepA; const char* cB = (const char*)S.opB(cur, g) + (size_t)cur.pn * tstepB;
    S.a_ready(cur);
    if constexpr (SP2) {
        PG8_STAGE(PG8_SB(0, 0), cB, voffB); PG8_STAGE(PG8_SB(0, 1), cB + hstepB, voffB); PG8_STAGE(PG8_SA(0, 0), cA, voffA); PG8_STAGE(PG8_SA(0, 1), cA + hstepA, voffA);
        if (wr == 1) PG8_BAR;
        PG8_WAIT_V(2); PG8_BAR;
        PG8_STAGE(PG8_SB(1, 0), cB + kstep, voffB); PG8_STAGE(PG8_SA(1, 0), cA + kstep, voffA); PG8_STAGE(PG8_SB(1, 1), cB + hstepB + kstep, voffB);
        PG8_WAIT_V(6); PG8_BAR;
    } else {
        PG8_STAGE(PG8_SB(0, 0), cB, voffB); PG8_STAGE(PG8_SA(0, 0), cA, voffA); PG8_STAGE(PG8_SB(0, 1), cB + hstepB, voffB); PG8_STAGE(PG8_SA(0, 1), cA + hstepA, voffA);
        if (wr == 1) PG8_BAR;
        PG8_WAIT_V(4); PG8_BAR;
        PG8_STAGE(PG8_SB(1, 0), cB + kstep, voffB); PG8_STAGE(PG8_SA(1, 0), cA + kstep, voffA); PG8_STAGE(PG8_SB(1, 1), cB + hstepB + kstep, voffB);
        PG8_WAIT_V(6); PG8_BAR;
    }
    for (;;) {
        const bool has_next = S.next(ui + 1, nxt);
        const char* nA = has_next ? (const char*)S.opA(nxt, g) + (size_t)nxt.pm * tstepA : cA; const char* nB = has_next ? (const char*)S.opB(nxt, g) + (size_t)nxt.pn * tstepB : cB;
        for (int t = 0; t < nt; t += 2) {
            const bool last = (t == nt - 2);
            const char* a1 = cA + (size_t)(t + 1) * kstep;
            const char* a2 = last ? nA : cA + (size_t)(t + 2) * kstep; const char* b2 = last ? nB : cB + (size_t)(t + 2) * kstep;
            const char* a3 = a2 + kstep; const char* b3 = b2 + kstep;
            if (last && has_next) S.a_ready(nxt);
            if constexpr (SP2) {
            PG8_LDB(B0, 0, 0); PG8_LDB(B1, 0, 1); PG8_SCHED; PG8_LDA(At, 0, 0); PG8_STAGE(PG8_SA(1, 1), a1 + hstepA, voffA);
            PG8_WAIT_V(8); PG8_WAIT_L(0); PG8_BAR; PG8_MMA(0, 0, At, B0); PG8_MMA(0, 1, At, B1); PG8_BAR; PG8_SCHED;
            PG8_LDA(At, 0, 1); PG8_STAGE(PG8_SB(0, 0), b2, voffB); PG8_STAGE(PG8_SB(0, 1), b2 + hstepB, voffB); PG8_STAGE(PG8_SA(0, 0), a2, voffA);
            PG8_WAIT_V(8); PG8_WAIT_L(0); PG8_BAR; PG8_MMA(1, 0, At, B0); PG8_MMA(1, 1, At, B1); PG8_BAR; PG8_SCHED;
            PG8_LDB(B0, 1, 0); PG8_LDB(B1, 1, 1); PG8_SCHED; PG8_LDA(At, 1, 0); PG8_STAGE(PG8_SA(0, 1), a2 + hstepA, voffA);
            PG8_WAIT_V(8); PG8_WAIT_L(0); PG8_BAR; PG8_MMA(0, 0, At, B0); PG8_MMA(0, 1, At, B1); PG8_BAR; PG8_SCHED;
            PG8_LDA(At, 1, 1); PG8_STAGE(PG8_SB(1, 0), b3, voffB); PG8_STAGE(PG8_SB(1, 1), b3 + hstepB, voffB); PG8_STAGE(PG8_SA(1, 0), a3, voffA);
            PG8_WAIT_V(8); PG8_WAIT_L(0); PG8_BAR; PG8_MMA(1, 0, At, B0); PG8_MMA(1, 1, At, B1); PG8_BAR; PG8_SCHED;
            } else {
            PG8_LDB(B0, 0, 0); PG8_SCHED; PG8_LDA(At, 0, 0); PG8_STAGE(PG8_SA(1, 1), a1 + hstepA, voffA);
            PG8_WAIT_L(8); PG8_BAR; PG8_WAIT_L(0); PG8_MMA(0, 0, At, B0); PG8_BAR; PG8_SCHED;
            PG8_LDB(B1, 0, 1); PG8_STAGE(PG8_SB(0, 0), b2, voffB);
            PG8_BAR; PG8_WAIT_L(0); PG8_MMA(0, 1, At, B1); PG8_BAR;
            PG8_LDA(At, 0, 1); PG8_STAGE(PG8_SA(0, 0), a2, voffA);
            PG8_BAR; PG8_WAIT_L(0); PG8_MMA(1, 0, At, B0); PG8_BAR; PG8_SCHED;
            PG8_STAGE(PG8_SB(0, 1), b2 + hstepB, voffB);
            PG8_WAIT_V(6); PG8_BAR; PG8_MMA(1, 1, At, B1); PG8_BAR;
            PG8_LDB(B0, 1, 0); PG8_SCHED; PG8_LDA(At, 1, 0); PG8_STAGE(PG8_SA(0, 1), a2 + hstepA, voffA);
            PG8_WAIT_L(8); PG8_BAR; PG8_WAIT_L(0); PG8_MMA(0, 0, At, B0); PG8_BAR; PG8_SCHED;
            PG8_LDB(B1, 1, 1); PG8_STAGE(PG8_SB(1, 0), b3, voffB);
            PG8_BAR; PG8_WAIT_L(0); PG8_MMA(0, 1, At, B1); PG8_BAR;
            PG8_LDA(At, 1, 1); PG8_STAGE(PG8_SA(1, 0), a3, voffA);
            PG8_BAR; PG8_WAIT_L(0); PG8_MMA(1, 0, At, B0); PG8_BAR; PG8_SCHED;
            PG8_STAGE(PG8_SB(1, 1), b3 + hstepB, voffB);
            PG8_WAIT_V(6); PG8_BAR; PG8_MMA(1, 1, At, B1); PG8_BAR;
            }
        }
        if constexpr (ALIGN_EPI) { if (wr == 0) PG8_BAR; }
        if constexpr (!Epi::AFTER_DRAIN) { E(acc, cur, wr, wc, fr, fq); S.done(cur); }
        if (!has_next) break;
#pragma unroll
        for (int a = 0; a < 2; ++a)
#pragma unroll
            for (int b = 0; b < 2; ++b)
#pragma unroll
                for (int m = 0; m < 4; ++m)
#pragma unroll
                    for (int n = 0; n < 2; ++n) acc[a][b][m][n] = (f32x4){0.f, 0.f, 0.f, 0.f};
        cur = nxt; cA = nA; cB = nB; ++ui;
        if constexpr (ALIGN_EPI) { if (wr == 1) PG8_BAR; }
    }
    PG8_WAIT_V(0);
    if constexpr (!ALIGN_EPI) { if (wr == 0) PG8_BAR; }
    PG8_BAR;
    if constexpr (Epi::AFTER_DRAIN) { E.fused(acc, cur, wr, wc, fr, fq, lds, wid, lane); S.done(cur); }
#undef PG8_SA
#undef PG8_SB
#undef PG8_STAGE
#undef PG8_LDA
#undef PG8_LDB
#undef PG8_MMA
#undef PG8_WAIT_V
#undef PG8_WAIT_L
#undef PG8_BAR
#undef PG8_SCHED
}
}

#define LAS __attribute__((address_space(3)))
typedef pg8::bf16_t bf16_t;
typedef pg8::bf16x8 bf16x8;
typedef pg8::f32x4 f32x4;
typedef pg8::u32x4 u32x4;
typedef float f32x16 __attribute__((ext_vector_type(16)));
typedef float f32x2v __attribute__((ext_vector_type(2)));
typedef unsigned u32x2 __attribute__((ext_vector_type(2)));
typedef short s16x4 __attribute__((ext_vector_type(4)));

constexpr int D = 1024, SEQ = 8192, MP = 16384, MS = 1024, M = MP + MS, NL = 2, DECB = 128, DECT = 8;
constexpr int NIN = 9216, FF = 4096, NBROW = 130, MODLD = 12288;
constexpr float EPS = 1e-6f;
constexpr int NWAVES = 8, NTHR = 512;
constexpr int LDS_BYTES = 147456, BAR_LDS_OFF = 147456 - 256;
constexpr size_t BAR_BYTES = 16384;

constexpr size_t MiB = 1u << 20;
constexpr size_t WS_WIN = 1 * MiB, WS_WAO = 19 * MiB, WS_WA = 21 * MiB, WS_WB = 22 * MiB, WS_WC = 23 * MiB, WS_WO = 24 * MiB, WS_WSP = 26 * MiB;
constexpr size_t WS_MOD = 27 * MiB, WS_H = 39 * MiB, WS_G = 73 * MiB, WS_R1 = 209 * MiB;
constexpr size_t WS_Q = WS_R1, WS_KV = WS_Q + 34 * MiB, WS_GLU = WS_KV + 17 * MiB, WS_CGH = WS_GLU + 17 * MiB, WS_VV = WS_CGH + 17 * MiB, WS_BG = WS_VV + 17 * MiB, WS_U = WS_BG + 17 * MiB;
constexpr size_t WS_WUP = WS_U + 17 * MiB, WS_WDN = WS_WUP + 8 * MiB;
constexpr size_t WS_END = WS_WDN + 8 * MiB;
constexpr size_t WS_WADA = WS_G, WS_CS = WS_R1, WS_AACT = WS_H, WS_MG = WS_KV;

constexpr size_t O_PA = 17825792, O_SA = 17887232, O_PB = 21819392, O_SB = 21823488, O_PK = 22085632, O_SK = 22216704, O_PV = 30605312, O_SV = 30736384, O_SG = 39124992;

__device__ __forceinline__ unsigned cvtpk(float lo, float hi) { return pg8::cvt_pk_bf16(lo, hi); }
__device__ __forceinline__ float bflo(unsigned w) { return __uint_as_float(w << 16); }
__device__ __forceinline__ float bfhi(unsigned w) { return __uint_as_float(w & 0xffff0000u); }
__device__ __forceinline__ float bf2f(bf16_t h) { return __uint_as_float((unsigned)h << 16); }
__device__ __forceinline__ bf16_t f2bf(float f) { return (bf16_t)(cvtpk(f, 0.f) & 0xffffu); }
__device__ __forceinline__ float sigm(float x) { return __builtin_amdgcn_rcpf(1.f + __builtin_amdgcn_exp2f(-1.4426950408889634f * x)); }
__device__ __forceinline__ float gelu_t(float x) { const float u = 1.5957691216057308f * (x + 0.044715f * x * x * x); return x * sigm(u); }
__device__ __forceinline__ float wave_sum(float v) {
#pragma unroll
    for (int o = 1; o < 64; o <<= 1) v += __shfl_xor(v, o);
    return v;
}
__device__ __forceinline__ int bidx(int r) { return r < MP ? (r >> 13) : 2 + ((r - MP) >> 3); }
__device__ __forceinline__ int crow(int r, int hi) { return (r & 3) + 8 * (r >> 2) + 4 * hi; }
__device__ __forceinline__ void store8(bf16_t* p, f32x4 a, f32x4 b) {
    u32x4 w; w.x = cvtpk(a[0], a[1]); w.y = cvtpk(a[2], a[3]); w.z = cvtpk(b[0], b[1]); w.w = cvtpk(b[2], b[3]); *(u32x4*)p = w;
}

__device__ __forceinline__ unsigned q8(float s) { return (unsigned)(s * 255.f + 0.5f); }
__device__ __forceinline__ unsigned pack4_q8(float a, float b, float c, float d) { return q8(a) | (q8(b) << 8) | (q8(c) << 16) | (q8(d) << 24); }
__device__ __forceinline__ float ub(unsigned w, int k) { return (float)((w >> (8 * k)) & 0xffu) * (1.f / 255.f); }
namespace epi {
using namespace pg8;
struct BranchOrder {
    StaticOrder so; const bf16_t *A0, *A1, *A2, *B0, *B1, *B2;
    __device__ __forceinline__ bool next(int i, Unit& u) const { if (i >= 3) return false; Unit t; if (!so.next(0, t)) return false; u.pm = t.pm; u.pn = t.pn; u.aux = i; return true; }
    template <class G_> __device__ __forceinline__ const bf16_t* opA(const Unit& u, const G_&) const { return u.aux == 0 ? A0 : u.aux == 1 ? A1 : A2; }
    template <class G_> __device__ __forceinline__ const bf16_t* opB(const Unit& u, const G_&) const { return u.aux == 0 ? B0 : u.aux == 1 ? B1 : B2; }
    __device__ __forceinline__ void a_ready(const Unit&) const {}
    __device__ __forceinline__ void done(const Unit&) const {}
};
struct EpiIn {
    static constexpr bool PERM = true, AFTER_DRAIN = false;
    bf16_t *Q, *KV, *GLU, *BG, *CGH, *U, *VV, *G;
    __device__ __forceinline__ void operator()(const f32x4 (&acc)[2][2][4][2], const Unit& u, int wr, int wc, int fr, int fq) const {
        const int pn = u.pn;
        bf16_t* dst; int ld, c0, act = 0, pair = 0;
        if (pn < 4) { dst = Q; ld = 1024; c0 = 256 * pn; }
        else if (pn < 6) { dst = KV; ld = 512; c0 = 256 * (pn - 4); }
        else if (pn < 10) { dst = GLU; ld = 512; c0 = 128 * (pn - 6); pair = 1; }
        else if (pn < 12) { dst = BG; ld = 512; c0 = 256 * (pn - 10); }
        else if (pn < 16) { dst = CGH; ld = 512; c0 = 128 * (pn - 12); pair = 2; }
        else if (pn < 18) { dst = U; ld = 512; c0 = 256 * (pn - 16); act = 2; }
        else if (pn < 20) { dst = VV; ld = 512; c0 = 256 * (pn - 18); act = 2; }
        else { dst = G; ld = 4096; c0 = 256 * (pn - 20); act = 3; }
        const int row0 = u.pm * BM + wr * 64 + fr, col0 = c0 + wc * 32 + 8 * fq;
#pragma unroll
        for (int ai = 0; ai < 2; ++ai)
#pragma unroll
            for (int m = 0; m < 4; ++m) {
                bf16_t* rowp = dst + (size_t)(row0 + ai * HALF + m * 16) * ld + col0;
                if (pair) {
                    f32x4 a0 = acc[ai][0][m][0], a1 = acc[ai][0][m][1], g0 = acc[ai][1][m][0], g1 = acc[ai][1][m][1];
                    if (pair == 1) {
#pragma unroll
                        for (int i = 0; i < 4; ++i) { g0[i] = sigm(g0[i]); g1[i] = sigm(g1[i]); }
                    }
                    store8(rowp, a0 * g0, a1 * g1);
                } else {
#pragma unroll
                    for (int bj = 0; bj < 2; ++bj) {
                        f32x4 v0 = acc[ai][bj][m][0], v1 = acc[ai][bj][m][1];
                        if (act == 3) {
#pragma unroll
                            for (int i = 0; i < 4; ++i) { v0[i] = sigm(v0[i]); v1[i] = sigm(v1[i]); }
                            u32x2 w; w.x = pack4_q8(v0[0], v0[1], v0[2], v0[3]); w.y = pack4_q8(v1[0], v1[1], v1[2], v1[3]);
                            *(u32x2*)((unsigned char*)dst + (size_t)(row0 + ai * HALF + m * 16) * 4096 + col0 + bj * HALF) = w;
                            continue;
                        } else if (act == 2) {
#pragma unroll
                            for (int i = 0; i < 4; ++i) { v0[i] = gelu_t(v0[i]); v1[i] = gelu_t(v1[i]); }
                        }
                        store8(rowp + bj * HALF, v0, v1);
                    }
                }
            }
    }
};
struct EpiUp {
    static constexpr bool PERM = true, AFTER_DRAIN = false;
    bf16_t* O; int ld;
    __device__ __forceinline__ void operator()(const f32x4 (&acc)[2][2][4][2], const Unit& u, int wr, int wc, int fr, int fq) const {
        const int row0 = u.pm * BM + wr * 64 + fr, col0 = u.pn * BM + wc * 32 + 8 * fq;
#pragma unroll
        for (int ai = 0; ai < 2; ++ai)
#pragma unroll
            for (int m = 0; m < 4; ++m) {
                bf16_t* rowp = O + (size_t)(row0 + ai * HALF + m * 16) * ld + col0;
#pragma unroll
                for (int bj = 0; bj < 2; ++bj) {
                    f32x4 v0 = acc[ai][bj][m][0], v1 = acc[ai][bj][m][1];
#pragma unroll
                    for (int i = 0; i < 4; ++i) { const float a = fmaxf(v0[i], 0.f), b = fmaxf(v1[i], 0.f); v0[i] = a * a; v1[i] = b * b; }
                    store8(rowp + bj * HALF, v0, v1);
                }
            }
    }
};
struct EpiBranch {
    static constexpr bool PERM = true, AFTER_DRAIN = false;
    bf16_t* MG; const unsigned char* Gb; int br0;
    __device__ __forceinline__ void operator()(const f32x4 (&acc)[2][2][4][2], const Unit& u, int wr, int wc, int fr, int fq) const {
        const int row0 = u.pm * BM + wr * 64 + fr, col0 = u.pn * BM + wc * 32 + 8 * fq;
        const int br = br0 + u.aux; const bool first = br == 0; const unsigned char* Gt = Gb + br * 1024;
        u32x2 gw[2][4][2];
#pragma unroll
        for (int ai = 0; ai < 2; ++ai)
#pragma unroll
            for (int m = 0; m < 4; ++m)
#pragma unroll
                for (int bj = 0; bj < 2; ++bj) gw[ai][m][bj] = *(const u32x2*)(Gt + (size_t)(row0 + ai * HALF + m * 16) * 4096 + col0 + bj * HALF);
#pragma unroll
        for (int ai = 0; ai < 2; ++ai) {
            u32x4 mw[4][2];
#pragma unroll
            for (int m = 0; m < 4; ++m)
#pragma unroll
                for (int bj = 0; bj < 2; ++bj) {
                    const size_t r = (size_t)(row0 + ai * HALF + m * 16); const int c = col0 + bj * HALF;
                    if (!first) mw[m][bj] = *(const u32x4*)(MG + r * 1024 + c); else mw[m][bj] = (u32x4){0u, 0u, 0u, 0u};
                }
#pragma unroll
            for (int m = 0; m < 4; ++m)
#pragma unroll
                for (int bj = 0; bj < 2; ++bj) {
                    const size_t r = (size_t)(row0 + ai * HALF + m * 16); const int c = col0 + bj * HALF;
                    const u32x2 g = gw[ai][m][bj]; const u32x4 o = mw[m][bj];
                    f32x4 v0 = acc[ai][bj][m][0], v1 = acc[ai][bj][m][1];
                    v0[0] = v0[0] * ub(g.x, 0) + bflo(o.x); v0[1] = v0[1] * ub(g.x, 1) + bfhi(o.x); v0[2] = v0[2] * ub(g.x, 2) + bflo(o.y); v0[3] = v0[3] * ub(g.x, 3) + bfhi(o.y);
                    v1[0] = v1[0] * ub(g.y, 0) + bflo(o.z); v1[1] = v1[1] * ub(g.y, 1) + bfhi(o.z); v1[2] = v1[2] * ub(g.y, 2) + bflo(o.w); v1[3] = v1[3] * ub(g.y, 3) + bfhi(o.w);
                    store8(MG + r * 1024 + c, v0, v1);
                }
        }
    }
};
struct EpiRes {
    static constexpr bool PERM = false, AFTER_DRAIN = false;
    float* X; const float* gate; const float* base;
    __device__ __forceinline__ void operator()(const f32x4 (&acc)[2][2][4][2], const Unit& u, int wr, int wc, int fr, int fq) const {
        const int row0 = u.pm * BM + wr * 64 + fr, col0 = u.pn * BM + wc * 32 + 4 * fq;
        const float* gp = gate + (size_t)bidx(u.pm * BM) * MODLD + col0;
        f32x4 g[2][2];
#pragma unroll
        for (int bj = 0; bj < 2; ++bj)
#pragma unroll
            for (int n = 0; n < 2; ++n) g[bj][n] = *(const f32x4*)(gp + bj * HALF + n * 16);
#pragma unroll
        for (int ai = 0; ai < 2; ++ai) {
            f32x4 x[4][2][2];
#pragma unroll
            for (int m = 0; m < 4; ++m)
#pragma unroll
                for (int bj = 0; bj < 2; ++bj)
#pragma unroll
                    for (int n = 0; n < 2; ++n) x[m][bj][n] = *(const f32x4*)(base + (size_t)(row0 + ai * HALF + m * 16) * 1024 + col0 + bj * HALF + n * 16);
#pragma unroll
            for (int m = 0; m < 4; ++m)
#pragma unroll
                for (int bj = 0; bj < 2; ++bj)
#pragma unroll
                    for (int n = 0; n < 2; ++n)
                        *(f32x4*)(X + (size_t)(row0 + ai * HALF + m * 16) * 1024 + col0 + bj * HALF + n * 16) = x[m][bj][n] + g[bj][n] * acc[ai][bj][m][n];
        }
    }
};
struct EpiMod {
    static constexpr bool PERM = false, AFTER_DRAIN = false;
    float* O; const float* bias;
    __device__ __forceinline__ void operator()(const f32x4 (&acc)[2][2][4][2], const Unit& u, int wr, int wc, int fr, int fq) const {
        const int row0 = u.pm * BM + wr * 64 + fr, col0 = u.pn * BM + wc * 32 + 4 * fq;
#pragma unroll
        for (int ai = 0; ai < 2; ++ai)
#pragma unroll
            for (int m = 0; m < 4; ++m) {
                const int r = row0 + ai * HALF + m * 16;
                if (r < NBROW) {
#pragma unroll
                    for (int bj = 0; bj < 2; ++bj)
#pragma unroll
                        for (int n = 0; n < 2; ++n) {
                            const int c = col0 + bj * HALF + n * 16;
                            *(f32x4*)(O + (size_t)r * MODLD + c) = acc[ai][bj][m][n] + *(const f32x4*)(bias + c);
                        }
                }
            }
    }
};
}


#define RLX_AGENT __ATOMIC_RELAXED, __HIP_MEMORY_SCOPE_AGENT
#define LDS_WAIT() asm volatile("s_waitcnt lgkmcnt(0)" ::: "memory")
#define VM_WAIT() asm volatile("s_waitcnt vmcnt(0)" ::: "memory")
__device__ __forceinline__ unsigned long long rt() { return __builtin_amdgcn_s_memrealtime(); }
#define XB_TMO      128
#define XB_XCNT(j)  (256  + 64 * (j))
#define XB_XSUB(j)  (1280 + 64 * (j))
#define XB_XGEN(j)  (2304 + 64 * (j))
#define XB_TOP      3328
#define XB_TOPGEN   3392
#define XCD_BAR_WORDS 3456
#define XB_SPIN_CAP (1u << 18)

__device__ __forceinline__ unsigned xb_ld(unsigned* p)              { return __hip_atomic_load(p, __ATOMIC_RELAXED, __HIP_MEMORY_SCOPE_AGENT); }
__device__ __forceinline__ unsigned xb_add(unsigned* p, unsigned v) { return __hip_atomic_fetch_add(p, v, __ATOMIC_RELAXED, __HIP_MEMORY_SCOPE_AGENT); }
__device__ __forceinline__ unsigned xb_xcc_id() { return (unsigned)__builtin_amdgcn_s_getreg((3 << 11) | 20) & 0xFu; }
#define XB_SPIN(cond, bar) do { unsigned _sp = 0; while (cond) { __builtin_amdgcn_s_sleep(1); \
    if ((++_sp & 255u) == 0u) { if (xb_ld(&(bar)[XB_TMO])) break; if (_sp > XB_SPIN_CAP) { atomicAdd(&(bar)[XB_TMO], 1u); break; } } } } while (0)

struct XcdBarrier {
    unsigned* bar; unsigned x;
    volatile LAS unsigned* st;
};

__device__ __forceinline__ XcdBarrier xcd_barrier_post(unsigned* bar, volatile LAS unsigned* st) {
    XcdBarrier b; b.bar = bar; b.x = xb_xcc_id(); b.st = st;
    if (threadIdx.x == 0) (void)xb_add(&bar[XB_XCNT(b.x)], 1u);
    return b;
}
__device__ __forceinline__ void xcd_barrier_complete(unsigned* bar, unsigned x, unsigned& nloc, unsigned& nx) {
    const unsigned G = gridDim.x * gridDim.y * gridDim.z;
    unsigned sum, cnt, mine, sp = 0u;
    for (;;) {
        sum = 0u; cnt = 0u; mine = 0u;
#pragma unroll
        for (unsigned j = 0; j < 16; ++j) { const unsigned c = xb_ld(&bar[XB_XCNT(j)]); sum += c; cnt += (c > 0u) ? 1u : 0u; mine = (j == x) ? c : mine; }
        if (sum == G) break;
        __builtin_amdgcn_s_sleep(1);
        if ((++sp & 255u) == 0u) { if (xb_ld(&bar[XB_TMO])) break; if (sp > XB_SPIN_CAP) { atomicAdd(&bar[XB_TMO], 1u); break; } }
    }
    nloc = mine > 0u ? mine : 1u; nx = cnt > 0u ? cnt : 1u;
}

__device__ __forceinline__ void xcd_barrier(const XcdBarrier& b) {
    asm volatile("s_waitcnt vmcnt(0)" ::: "memory");
    __syncthreads();
    if (threadIdx.x == 0) {
        unsigned* bar = b.bar;
        __builtin_amdgcn_s_waitcnt(0);
        unsigned nloc = b.st[0], nx = b.st[1];
        if (nloc == 0u) { xcd_barrier_complete(bar, b.x, nloc, nx); b.st[0] = nloc; b.st[1] = nx; }
        const unsigned old = xb_add(&bar[XB_XSUB(b.x)], 1u);
        const unsigned gen = old / nloc;
        if (old + 1u == (gen + 1u) * nloc) {
            __builtin_amdgcn_fence(__ATOMIC_RELEASE, "agent");
            asm volatile("s_waitcnt vmcnt(0)" ::: "memory");
            const unsigned og = xb_add(&bar[XB_TOP], 1u);
            const unsigned tg = og / nx;
            if (og + 1u == (tg + 1u) * nx) xb_add(&bar[XB_TOPGEN], 1u);
            else XB_SPIN(xb_ld(&bar[XB_TOPGEN]) == tg, bar);
            __builtin_amdgcn_fence(__ATOMIC_ACQUIRE, "agent");
            xb_add(&bar[XB_XGEN(b.x)], 1u);
            asm volatile("s_waitcnt vmcnt(0)" ::: "memory");
        } else {
            XB_SPIN(xb_ld(&bar[XB_XGEN(b.x)]) == gen, bar);
            __builtin_amdgcn_fence(__ATOMIC_ACQUIRE, "agent");
            asm volatile("s_waitcnt vmcnt(0)" ::: "memory");
        }
    }
    __syncthreads();
}

struct Args {
    const float* in[32]; float* out; unsigned char* ws; int nprog; unsigned char prog[60];
};

struct Ctx { int tid, lane, wave, gw, NGW, bid, G; };
__device__ __forceinline__ Ctx make_ctx() {
    int tid = threadIdx.x; asm volatile("" : "+v"(tid));
    int bid = blockIdx.x; asm volatile("" : "+s"(bid));
    Ctx c; c.tid = tid; c.lane = tid & 63; c.wave = __builtin_amdgcn_readfirstlane(tid >> 6); c.bid = bid; c.G = gridDim.x;
    c.gw = bid * NWAVES + c.wave; c.NGW = c.G * NWAVES; return c;
}

constexpr int SP_LD = 132;
template <class EpiS>
__device__ __forceinline__ void small_gemm(LAS unsigned char* lds, const bf16_t* A, int lda, const bf16_t* Bt, int ldb, int K, int N, const EpiS& E, const Ctx& c) {
    const int lane = c.lane, fr = lane & 15, fq = lane >> 4, w = c.wave;
    const int nct = N / 128, kw = K / 8;
    LAS float* P = (LAS float*)lds;
    for (int u = c.bid; u < 32 * nct; u += c.G) {
        const int ct = u % nct, rt = u / nct, r0 = 32 * rt, n0 = 128 * ct;
        f32x4 acc[2][8];
#pragma unroll
        for (int mt = 0; mt < 2; ++mt)
#pragma unroll
            for (int nt = 0; nt < 8; ++nt) acc[mt][nt] = (f32x4){0.f, 0.f, 0.f, 0.f};
        const bf16_t* ap = A + (size_t)(r0 + fr) * lda + w * kw + 8 * fq;
        const bf16_t* bp = Bt + (size_t)(n0 + fr) * ldb + w * kw + 8 * fq;
        bf16x8 a0[2], b0[8], a1[2], b1[8];
#define SG_LOAD(AF, BF, K0) do { _Pragma("unroll") for (int mt = 0; mt < 2; ++mt) AF[mt] = *(const bf16x8*)(ap + (size_t)16 * mt * lda + (K0)); \
        _Pragma("unroll") for (int nt = 0; nt < 8; ++nt) BF[nt] = *(const bf16x8*)(bp + (size_t)16 * nt * ldb + (K0)); } while (0)
#define SG_MMA(AF, BF) do { _Pragma("unroll") for (int mt = 0; mt < 2; ++mt) _Pragma("unroll") for (int nt = 0; nt < 8; ++nt) \
        acc[mt][nt] = __builtin_amdgcn_mfma_f32_16x16x32_bf16(BF[nt], AF[mt], acc[mt][nt], 0, 0, 0); } while (0)
        SG_LOAD(a0, b0, 0);
        for (int k0 = 0; k0 < kw; k0 += 64) {
            SG_LOAD(a1, b1, k0 + 32);
            SG_MMA(a0, b0);
            if (k0 + 64 < kw) SG_LOAD(a0, b0, k0 + 64);
            SG_MMA(a1, b1);
        }
#undef SG_LOAD
#undef SG_MMA
        LAS float* pw = P + w * 32 * SP_LD;
#pragma unroll
        for (int mt = 0; mt < 2; ++mt)
#pragma unroll
            for (int nt = 0; nt < 8; ++nt) *(LAS f32x4*)(pw + (16 * mt + fr) * SP_LD + 16 * nt + 4 * fq) = acc[mt][nt];
        __syncthreads();
        const int row = c.tid >> 4, c8 = (c.tid & 15) * 8;
        f32x4 v0 = (f32x4){0.f, 0.f, 0.f, 0.f}, v1 = v0;
#pragma unroll
        for (int ww = 0; ww < 8; ++ww) { v0 += *(const LAS f32x4*)(P + (ww * 32 + row) * SP_LD + c8); v1 += *(const LAS f32x4*)(P + (ww * 32 + row) * SP_LD + c8 + 4); }
        E(r0 + row, n0 + c8, v0, v1);
        __syncthreads();
    }
}
struct EpiSRes {
    float* X; const float* gate; const float* base;
    __device__ __forceinline__ void operator()(int row, int col, f32x4 v0, f32x4 v1) const {
        const float* gp = gate + (size_t)(2 + (row >> 3)) * MODLD + col;
        float* xp = X + (size_t)(MP + row) * 1024 + col;
        const float* bp = base + (size_t)row * 1024 + col;
        const f32x4 g0 = *(const f32x4*)gp, g1 = *(const f32x4*)(gp + 4);
        f32x4 x0 = *(const f32x4*)bp, x1 = *(const f32x4*)(bp + 4);
        x0 += g0 * v0; x1 += g1 * v1;
        *(f32x4*)xp = x0; *(f32x4*)(xp + 4) = x1;
    }
};
struct EpiSUp {
    bf16_t* O;
    __device__ __forceinline__ void operator()(int row, int col, f32x4 v0, f32x4 v1) const {
#pragma unroll
        for (int i = 0; i < 4; ++i) { const float a = fmaxf(v0[i], 0.f), b = fmaxf(v1[i], 0.f); v0[i] = a * a; v1[i] = b * b; }
        store8(O + (size_t)(MP + row) * FF + col, v0, v1);
    }
};
struct EpiSBranch {
    bf16_t* MG; const unsigned char* Gt; int first;
    __device__ __forceinline__ void operator()(int row, int col, f32x4 v0, f32x4 v1) const {
        const size_t r = (size_t)(MP + row);
        const u32x2 gw = *(const u32x2*)(Gt + r * 4096 + col);
        v0[0] *= ub(gw.x, 0); v0[1] *= ub(gw.x, 1); v0[2] *= ub(gw.x, 2); v0[3] *= ub(gw.x, 3);
        v1[0] *= ub(gw.y, 0); v1[1] *= ub(gw.y, 1); v1[2] *= ub(gw.y, 2); v1[3] *= ub(gw.y, 3);
        bf16_t* mp = MG + r * 1024 + col;
        if (!first) {
            const u32x4 mw = *(const u32x4*)mp;
            v0[0] += bflo(mw.x); v0[1] += bfhi(mw.x); v0[2] += bflo(mw.y); v0[3] += bfhi(mw.y);
            v1[0] += bflo(mw.z); v1[1] += bfhi(mw.z); v1[2] += bflo(mw.w); v1[3] += bfhi(mw.w);
        }
        store8(mp, v0, v1);
    }
};

__device__ __forceinline__ int perm_in(int s) {
    if (s >= 1536 && s < 2560) { const int o = s - 1536, bj = o >> 9, r = o & 511; return 1536 + ((r >> 7) << 8) + (bj << 7) + (r & 127); }
    if (s >= 3072 && s < 4096) { const int o = s - 3072, bj = o >> 9, r = o & 511; return 3072 + ((r >> 7) << 8) + (bj << 7) + (r & 127); }
    return s;
}
constexpr int TT_LD = 257;
__device__ __forceinline__ int transpose_tiles(const float* W, int K, int N, bf16_t* WT, int row_off, int mode, LAS float* tl, int base, int bid, int G, int tid) {
    const int ntn = N / 256, ntiles = (K / 64) * ntn, lane = tid & 63, wid = tid >> 6;
    int t = bid - base % G; if (t < 0) t += G;
    for (; t < ntiles; t += G) {
        const int kb = t / ntn, nb = t % ntn, k0 = 64 * kb, n0 = 256 * nb;
        float v[8][4];
#pragma unroll
        for (int i = 0; i < 8; ++i)
#pragma unroll
            for (int cc = 0; cc < 4; ++cc) v[i][cc] = W[(size_t)(k0 + 8 * wid + i) * N + n0 + 64 * cc + lane];
#pragma unroll
        for (int i = 0; i < 8; ++i)
#pragma unroll
            for (int cc = 0; cc < 4; ++cc) tl[(8 * wid + i) * TT_LD + 64 * cc + lane] = v[i][cc];
        __syncthreads();
        const int ch = tid & 7;
#pragma unroll
        for (int qq = 0; qq < 4; ++qq) {
            const int n = (tid >> 3) + 64 * qq;
            const LAS float* sp = tl + (8 * ch) * TT_LD + n;
            u32x4 o; o.x = cvtpk(sp[0 * TT_LD], sp[1 * TT_LD]); o.y = cvtpk(sp[2 * TT_LD], sp[3 * TT_LD]); o.z = cvtpk(sp[4 * TT_LD], sp[5 * TT_LD]); o.w = cvtpk(sp[6 * TT_LD], sp[7 * TT_LD]);
            const int dn = row_off + (mode == 1 ? perm_in(n0 + n) : n0 + n);
            *(u32x4*)(WT + (size_t)dn * K + k0 + 8 * ch) = o;
        }
        __syncthreads();
    }
    return base + ntiles;
}

__device__ __forceinline__ void adaln_rows(const float* xp, const float* xs, float* Xcopy, bf16_t* Hout, const float* g, const float* shift, const float* scale, const Ctx& c) {
    constexpr int RPI = 9;
    f32x4 gg[4];
#pragma unroll
    for (int j = 0; j < 4; ++j) gg[j] = *(const f32x4*)(g + 4 * (c.lane + 64 * j));
    for (int row0 = RPI * c.gw; row0 < M; row0 += RPI * c.NGW) {
        f32x4 v[RPI][4]; float ss[RPI];
#pragma unroll
        for (int rr = 0; rr < RPI; ++rr) {
            const int row = min(row0 + rr, M - 1);
            const float* src = row < MP ? xp + (size_t)row * D : xs + (size_t)(row - MP) * D;
#pragma unroll
            for (int j = 0; j < 4; ++j) v[rr][j] = *(const f32x4*)(src + 4 * (c.lane + 64 * j));
        }
        const int bA = bidx(row0), bB = bidx(min(row0 + RPI - 1, M - 1));
        const bool same_b = bA == bB;
        f32x4 ps1[4], ps0[4];
        if (same_b) {
#pragma unroll
            for (int j = 0; j < 4; ++j) { ps1[j] = *(const f32x4*)(scale + (size_t)bA * MODLD + 4 * (c.lane + 64 * j)); ps0[j] = *(const f32x4*)(shift + (size_t)bA * MODLD + 4 * (c.lane + 64 * j)); }
        } else {
#pragma unroll
            for (int j = 0; j < 4; ++j) { ps1[j] = (f32x4){0.f, 0.f, 0.f, 0.f}; ps0[j] = ps1[j]; }
        }
#pragma unroll
        for (int rr = 0; rr < RPI; ++rr) {
            float a = 0.f;
#pragma unroll
            for (int j = 0; j < 4; ++j) a += (v[rr][j][0] * v[rr][j][0] + v[rr][j][1] * v[rr][j][1]) + (v[rr][j][2] * v[rr][j][2] + v[rr][j][3] * v[rr][j][3]);
            ss[rr] = a;
        }
#pragma unroll
        for (int o = 1; o < 64; o <<= 1)
#pragma unroll
            for (int rr = 0; rr < RPI; ++rr) ss[rr] += __shfl_xor(ss[rr], o);
#pragma unroll
        for (int rr = 0; rr < RPI; ++rr) {
            const int row = row0 + rr;
            if (row < M) {
                const int b = bidx(row);
                const float* sh = shift + (size_t)b * MODLD; const float* sc = scale + (size_t)b * MODLD;
                const float rstd = 1.0f / sqrtf(ss[rr] * (1.f / D) + EPS);
#pragma unroll
                for (int j = 0; j < 4; ++j) {
                    const int col = 4 * (c.lane + 64 * j);
                    if (Xcopy) *(f32x4*)(Xcopy + (size_t)row * D + col) = v[rr][j];
                    const f32x4 s1 = same_b ? ps1[j] : *(const f32x4*)(sc + col), s0 = same_b ? ps0[j] : *(const f32x4*)(sh + col);
                    const f32x4 o = v[rr][j] * rstd * gg[j] * (s1 + 1.0f) + s0;
                    u32x2 w; w.x = cvtpk(o[0], o[1]); w.y = cvtpk(o[2], o[3]);
                    *(u32x2*)(Hout + (size_t)row * D + col) = w;
                }
            }
        }
    }
}

struct C0P {
    bf16_t *Q, *KV, *VV; const bf16_t *GLU, *CGH;
    const float *qg, *kg, *lncg, *lncb, *cache_k, *cache_v, *state_a; float* out; int l;
};
__device__ __forceinline__ void phase_c0(const C0P& p, const Ctx& c) {
    const int lane = c.lane, hl = lane >> 4, e = lane & 15;
    const double invf[8] = {1.0, 0.19392274474868576, 0.03760603093086393, 0.007292664737217109, 0.001414213562373095, 0.0002742481756762073, 5.318295896944988e-05, 1.031338537721246e-05};
    const f32x4 kgg = *(const f32x4*)(p.kg + 4 * e);
    const f32x4 lg0 = *(const f32x4*)(p.lncg + 8 * lane), lg1 = *(const f32x4*)(p.lncg + 8 * lane + 4), lb0 = *(const f32x4*)(p.lncb + 8 * lane), lb1 = *(const f32x4*)(p.lncb + 8 * lane + 4);
    auto do_row = [&](int row, u32x2 wk, u32x2 wvr, u32x4 wvv) {
        const int pos = row < MP ? (row & (SEQ - 1)) : MP + ((row - MP) & 7);
        float cs[4], sn[4];
#pragma unroll
        for (int i = 0; i < 4; ++i) {
            const int fi = 4 * (e & 1) + i;
            double iv = invf[0];
#pragma unroll
            for (int k = 1; k < 8; ++k) iv = (fi == k) ? invf[k] : iv;
            const double rev = (double)pos * iv * 0.15915494309189535;
            const float fr = (float)(rev - __builtin_rint(rev));
            cs[i] = __builtin_amdgcn_cosf(fr); sn[i] = __builtin_amdgcn_sinf(fr);
        }
        long kvo = -1;
        if (row < MP) { const int t = row & (SEQ - 1); if (t >= SEQ - 128) kvo = ((long)(p.l * 2 + (row >> 13)) * 128 + (t - (SEQ - 128))) * 256; }
        else { const int bs = (row - MP) >> 3, t = (row - MP) & 7; kvo = ((long)(p.l * DECB + bs) * 128 + 120 + t) * 256; }
        const size_t ok_base = row < MP ? O_PK : O_SK, ov_base = row < MP ? O_PV : O_SV;
        {
            f32x4 x = {bflo(wk.x), bfhi(wk.x), bflo(wk.y), bfhi(wk.y)};
            float ss = (x[0] * x[0] + x[1] * x[1]) + (x[2] * x[2] + x[3] * x[3]);
            ss += __shfl_xor(ss, 1); ss += __shfl_xor(ss, 2); ss += __shfl_xor(ss, 4); ss += __shfl_xor(ss, 8);
            const float rstd = 1.0f / sqrtf(ss * (1.f / 64.f) + EPS);
            x = x * rstd * kgg;
            f32x4 pr;
#pragma unroll
            for (int i = 0; i < 4; ++i) pr[i] = __shfl_xor(x[i], 2);
            if (e < 4) {
#pragma unroll
                for (int i = 0; i < 4; ++i) x[i] = (e < 2) ? (x[i] * cs[i] - pr[i] * sn[i]) : (x[i] * cs[i] + pr[i] * sn[i]);
            }
            u32x2 o; o.x = cvtpk(x[0], x[1]); o.y = cvtpk(x[2], x[3]);
            *(u32x2*)(p.KV + (size_t)row * 512 + hl * 64 + 4 * e) = o;
            if (kvo >= 0) *(f32x4*)(p.out + ok_base + kvo + hl * 64 + 4 * e) = x;
        }
        if (kvo >= 0) *(f32x4*)(p.out + ov_base + kvo + hl * 64 + 4 * e) = (f32x4){bflo(wvr.x), bfhi(wvr.x), bflo(wvr.y), bfhi(wvr.y)};
        {
            bf16_t* vp = p.VV + (size_t)row * 512 + 8 * lane;
            const u32x4 w = wvv;
            float v[8] = {bflo(w.x), bfhi(w.x), bflo(w.y), bfhi(w.y), bflo(w.z), bfhi(w.z), bflo(w.w), bfhi(w.w)};
            float s = 0.f;
#pragma unroll
            for (int i = 0; i < 8; ++i) s += v[i];
            const float mean = wave_sum(s) * (1.f / 512.f);
            float q = 0.f;
#pragma unroll
            for (int i = 0; i < 8; ++i) { v[i] -= mean; q += v[i] * v[i]; }
            const float rstd = 1.0f / sqrtf(wave_sum(q) * (1.f / 512.f) + EPS);
            f32x4 o0, o1;
#pragma unroll
            for (int i = 0; i < 4; ++i) { o0[i] = v[i] * rstd * lg0[i] + lb0[i]; o1[i] = v[4 + i] * rstd * lg1[i] + lb1[i]; }
            store8(vp, o0, o1);
            if (row >= MP) { float* og = p.out + O_SG + ((size_t)p.l * MS + (row - MP)) * 512 + 8 * lane; *(f32x4*)og = o0; *(f32x4*)(og + 4) = o1; }
        }
    };
    constexpr int RP = 4;
    for (int row0 = RP * c.gw; row0 < M; row0 += RP * c.NGW) {
        u32x2 wk[RP], wv[RP]; u32x4 wvv[RP];
#pragma unroll
        for (int rr = 0; rr < RP; ++rr) {
            const size_t row = (size_t)(row0 + rr);
            wk[rr] = *(const u32x2*)(p.KV + row * 512 + hl * 64 + 4 * e); wv[rr] = *(const u32x2*)(p.KV + row * 512 + 256 + hl * 64 + 4 * e);
            wvv[rr] = *(const u32x4*)(p.VV + row * 512 + 8 * lane);
        }
#pragma unroll
        for (int rr = 0; rr < RP; ++rr) do_row(row0 + rr, wk[rr], wv[rr], wvv[rr]);
    }
    const long gt = (long)c.gw * 64 + c.lane, NT = (long)c.NGW * 64;
    for (long i = gt; i < 2 * 30 * 128; i += NT) {
        const int b = (int)(i / (30 * 128)), r = (int)(i % (30 * 128)), j = r >> 7, c4 = (r & 127) * 4;
        const u32x2 w = *(const u32x2*)(p.GLU + ((size_t)b * SEQ + SEQ - 30 + j) * 512 + c4);
        *(f32x4*)(p.out + O_PA + (((size_t)p.l * 2 + b) * 30 + j) * 512 + c4) = (f32x4){bflo(w.x), bfhi(w.x), bflo(w.y), bfhi(w.y)};
    }
    for (long i0 = gt; i0 < (long)DECB * 30 * 128; i0 += 4 * NT) {
        f32x4 v[4]; size_t dsts[4]; bool ok[4];
#pragma unroll
        for (int u4 = 0; u4 < 4; ++u4) {
            const long i = i0 + u4 * NT; ok[u4] = i < (long)DECB * 30 * 128;
            const long ii = ok[u4] ? i : 0;
            const int b = (int)(ii / (30 * 128)), r = (int)(ii % (30 * 128)), j = r >> 7, c4 = (r & 127) * 4;
            if (j < 22) v[u4] = *(const f32x4*)(p.state_a + (((size_t)p.l * DECB + b) * 30 + j + 8) * 512 + c4);
            else { const u32x2 w = *(const u32x2*)(p.GLU + ((size_t)MP + b * 8 + (j - 22)) * 512 + c4); v[u4] = (f32x4){bflo(w.x), bfhi(w.x), bflo(w.y), bfhi(w.y)}; }
            dsts[u4] = (((size_t)p.l * DECB + b) * 30 + j) * 512 + c4;
        }
#pragma unroll
        for (int u4 = 0; u4 < 4; ++u4) if (ok[u4]) *(f32x4*)(p.out + O_SA + dsts[u4]) = v[u4];
    }
    for (long i = gt; i < 2 * 2 * 128; i += NT) {
        const int b = (int)(i / 256), r = (int)(i % 256), j = r >> 7, c4 = (r & 127) * 4;
        const u32x2 w = *(const u32x2*)(p.CGH + ((size_t)b * SEQ + SEQ - 2 + j) * 512 + c4);
        *(f32x4*)(p.out + O_PB + (((size_t)p.l * 2 + b) * 2 + j) * 512 + c4) = (f32x4){bflo(w.x), bfhi(w.x), bflo(w.y), bfhi(w.y)};
    }
    for (long i = gt; i < (long)DECB * 2 * 128; i += NT) {
        const int b = (int)(i / 256), r = (int)(i % 256), j = r >> 7, c4 = (r & 127) * 4;
        const u32x2 w = *(const u32x2*)(p.CGH + ((size_t)MP + b * 8 + 6 + j) * 512 + c4);
        *(f32x4*)(p.out + O_SB + (((size_t)p.l * DECB + b) * 2 + j) * 512 + c4) = (f32x4){bflo(w.x), bfhi(w.x), bflo(w.y), bfhi(w.y)};
    }
}

constexpr int KS_LD = 72, VT_LD = 264;
constexpr int KS_BYTES = 256 * KS_LD * 2, VT_BYTES = 64 * VT_LD * 2;

template <bool SAMPLE>
__device__ __forceinline__ void attn_wave(const LAS bf16_t* Ks, const LAS bf16_t* Vt, int kbase, int kmin, bf16_t* Qb  ,
                                          const float* sinks  , const float* qg, int pos_base, int lane) {
    const int q = lane & 31, hi = lane >> 5;
    auto rowoff = [&](int r) -> size_t { return SAMPLE ? (size_t)(r & 7) * 1024 + (r >> 3) * 64 : (size_t)r * 1024; };
    const bf16_t* Qp = Qb + rowoff(q);
    const int lo = SAMPLE ? (q & 7) : q;
    const float sink = (SAMPLE ? sinks[q >> 3] : sinks[0]) * 1.4426950408889634f;
    bf16x8 qf[4];
#pragma unroll
    for (int d0 = 0; d0 < 4; ++d0) qf[d0] = *(const bf16x8*)(Qp + 16 * d0 + 8 * hi);
    {
        float x[4][8]; float ssq = 0.f;
#pragma unroll
        for (int d0 = 0; d0 < 4; ++d0)
#pragma unroll
            for (int j = 0; j < 8; ++j) { x[d0][j] = bf2f((bf16_t)qf[d0][j]); ssq += x[d0][j] * x[d0][j]; }
        f32x4 qg0[4], qg1[4];
#pragma unroll
        for (int d0 = 0; d0 < 4; ++d0) { qg0[d0] = *(const f32x4*)(qg + 16 * d0 + 8 * hi); qg1[d0] = *(const f32x4*)(qg + 16 * d0 + 8 * hi + 4); }
        ssq += __shfl_xor(ssq, 32);
        const float rstd = 1.0f / sqrtf(ssq * (1.f / 64.f) + EPS);
#pragma unroll
        for (int d0 = 0; d0 < 4; ++d0) {
#pragma unroll
            for (int j = 0; j < 4; ++j) { x[d0][j] *= rstd * qg0[d0][j]; x[d0][4 + j] *= rstd * qg1[d0][j]; }
        }
        const int pos = pos_base + (SAMPLE ? (q & 7) : q);
        const double invf[8] = {1.0, 0.19392274474868576, 0.03760603093086393, 0.007292664737217109, 0.001414213562373095, 0.0002742481756762073, 5.318295896944988e-05, 1.031338537721246e-05};
#pragma unroll
        for (int j = 0; j < 8; ++j) {
            const double rev = (double)pos * invf[j] * 0.15915494309189535;
            const float fr = (float)(rev - __builtin_rint(rev));
            const float cs = __builtin_amdgcn_cosf(fr), sn = __builtin_amdgcn_sinf(fr);
            const float pr = __shfl_xor(x[0][j], 32);
            x[0][j] = hi == 0 ? (x[0][j] * cs - pr * sn) : (x[0][j] * cs + pr * sn);
        }
#pragma unroll
        for (int d0 = 0; d0 < 4; ++d0) {
            u32x4 w; w.x = cvtpk(x[d0][0], x[d0][1]); w.y = cvtpk(x[d0][2], x[d0][3]); w.z = cvtpk(x[d0][4], x[d0][5]); w.w = cvtpk(x[d0][6], x[d0][7]);
            qf[d0] = __builtin_bit_cast(bf16x8, w);
        }
    }
    f32x16 s[5];
#pragma unroll
    for (int t = 0; t < 5; ++t) {
        s[t] = (f32x16){0.f, 0.f, 0.f, 0.f, 0.f, 0.f, 0.f, 0.f, 0.f, 0.f, 0.f, 0.f, 0.f, 0.f, 0.f, 0.f};
        const LAS bf16_t* kp = Ks + (kbase + 32 * t + q) * KS_LD + 8 * hi;
#pragma unroll
        for (int d0 = 0; d0 < 4; ++d0) { const bf16x8 kf = *(const LAS bf16x8*)(kp + 16 * d0); s[t] = __builtin_amdgcn_mfma_f32_32x32x16_bf16(kf, qf[d0], s[t], 0, 0, 0); }
        asm volatile("" ::: "memory");
    }
    const float sc = 0.125f * 1.4426950408889634f;
#pragma unroll
    for (int r = 0; r < 16; ++r) {
        const int k0 = crow(r, hi);
        s[0][r] = (k0 >= lo) ? s[0][r] : -1e30f;
        s[4][r] = (k0 <= lo) ? s[4][r] : -1e30f;
    }
    if (kmin > 0) {
#pragma unroll
        for (int t = 0; t < 5; ++t)
#pragma unroll
            for (int r = 0; r < 16; ++r) s[t][r] = (kbase + 32 * t + crow(r, hi) >= kmin) ? s[t][r] : -1e30f;
    }
    float mraw = -1e30f;
#pragma unroll
    for (int t = 0; t < 5; ++t)
#pragma unroll
        for (int r = 0; r < 16; ++r) mraw = fmaxf(mraw, s[t][r]);
    float mx = fmaxf(mraw * sc, sink);
    mx = fmaxf(mx, __shfl_xor(mx, 32));
    float sum = 0.f;
    f32x16 o[2];
    o[0] = (f32x16){0.f, 0.f, 0.f, 0.f, 0.f, 0.f, 0.f, 0.f, 0.f, 0.f, 0.f, 0.f, 0.f, 0.f, 0.f, 0.f}; o[1] = o[0];
#pragma unroll
    for (int t = 0; t < 5; ++t) {
#pragma unroll
        for (int cc = 0; cc < 2; ++cc) {
            float pv[8];
#pragma unroll
            for (int j = 0; j < 8; ++j) { pv[j] = __builtin_amdgcn_exp2f(fmaxf(s[t][8 * cc + j] * sc - mx, -126.f)); sum += pv[j]; }
            u32x4 pw; pw.x = cvtpk(pv[0], pv[1]); pw.y = cvtpk(pv[2], pv[3]); pw.z = cvtpk(pv[4], pv[5]); pw.w = cvtpk(pv[6], pv[7]);
            const bf16x8 pa = __builtin_bit_cast(bf16x8, pw);
#pragma unroll
            for (int dt = 0; dt < 2; ++dt) {
                const LAS bf16_t* vp = Vt + (32 * dt + q) * VT_LD + kbase + 32 * t + 16 * cc + 4 * hi;
                const s16x4 v0 = *(const LAS s16x4*)vp, v1 = *(const LAS s16x4*)(vp + 8);
                const bf16x8 vb = (bf16x8){v0[0], v0[1], v0[2], v0[3], v1[0], v1[1], v1[2], v1[3]};
                o[dt] = __builtin_amdgcn_mfma_f32_32x32x16_bf16(pa, vb, o[dt], 0, 0, 0);
            }
        }
        asm volatile("" ::: "memory");
    }
    sum += __shfl_xor(sum, 32);
    sum += __builtin_amdgcn_exp2f(sink - mx);
    const float inv = 1.0f / sum;
#pragma unroll
    for (int r = 0; r < 16; ++r) {
        const int qr = crow(r, hi);
        const float iv = __shfl(inv, qr);
        bf16_t* op = Qb + rowoff(qr) + q;
        op[0] = f2bf(o[0][r] * iv); op[32] = f2bf(o[1][r] * iv);
    }
}

struct C1P {
    bf16_t *Q, *BG, *U, *AACT; const bf16_t *KV, *GLU, *CGH, *VV, *WSP;
    const float *sinks, *cache_k, *cache_v, *state_a, *state_b, *conv_a_w, *conv_a_b, *ln_a_g, *ln_a_b, *conv_b_w, *w_sp, *b_sp; int l; const float* qg; float* out;
};

__device__ __forceinline__ void transpose8x8(const u32x4 (&r)[8], u32x4 (&o)[8]) {
#pragma unroll
    for (int j = 0; j < 8; ++j)
#pragma unroll
        for (int k = 0; k < 4; ++k) {
            const unsigned a = r[2 * k][j >> 1], b = r[2 * k + 1][j >> 1];
            o[j][k] = (j & 1) ? ((a >> 16) | (b & 0xffff0000u)) : ((a & 0xffffu) | (b << 16));
        }
}
__device__ __forceinline__ void vt_scatter(LAS bf16_t* Vt, int ld, int d0, int row, u32x4 vv) {
    Vt[(d0 + 0) * ld + row] = (bf16_t)(vv.x & 0xffffu); Vt[(d0 + 1) * ld + row] = (bf16_t)(vv.x >> 16);
    Vt[(d0 + 2) * ld + row] = (bf16_t)(vv.y & 0xffffu); Vt[(d0 + 3) * ld + row] = (bf16_t)(vv.y >> 16);
    Vt[(d0 + 4) * ld + row] = (bf16_t)(vv.z & 0xffffu); Vt[(d0 + 5) * ld + row] = (bf16_t)(vv.z >> 16);
    Vt[(d0 + 6) * ld + row] = (bf16_t)(vv.w & 0xffffu); Vt[(d0 + 7) * ld + row] = (bf16_t)(vv.w >> 16);
}

__device__ __forceinline__ void phase_attn(const C1P& p, LAS unsigned char* lds, const Ctx& c) {
    const int tid = c.tid, wid = c.wave, lane = c.lane;
    LAS bf16_t* Ks = (LAS bf16_t*)lds; LAS bf16_t* Vt = (LAS bf16_t*)(lds + KS_BYTES);
    for (int u = c.bid; u < 2 * 4 * 64; u += c.G) {
        const int i = u & 63, kvh = (u >> 6) & 3, b = u >> 8;
        {
            u32x4 kk[4], vr[8], vo[8];
#pragma unroll
            for (int it = 0; it < 4; ++it) {
                const int id = tid + 512 * it, row = id >> 3, ch = id & 7, pos = (i - 1) * 128 + row;
                kk[it] = (u32x4){0u, 0u, 0u, 0u};
                if (pos >= 0) kk[it] = *(const u32x4*)(p.KV + ((size_t)b * SEQ + pos) * 512 + kvh * 64 + ch * 8);
            }
            const int sb = tid & 31, db = tid >> 5;
            if (tid < 256) {
#pragma unroll
                for (int r8 = 0; r8 < 8; ++r8) {
                    const int pos = (i - 1) * 128 + 8 * sb + r8;
                    vr[r8] = (u32x4){0u, 0u, 0u, 0u};
                    if (pos >= 0) vr[r8] = *(const u32x4*)(p.KV + ((size_t)b * SEQ + pos) * 512 + 256 + kvh * 64 + db * 8);
                }
            }
#pragma unroll
            for (int it = 0; it < 4; ++it) { const int id = tid + 512 * it, row = id >> 3, ch = id & 7; *(LAS u32x4*)(Ks + row * KS_LD + ch * 8) = kk[it]; }
            if (tid < 256) {
                transpose8x8(vr, vo);
#pragma unroll
                for (int j = 0; j < 8; ++j) *(LAS u32x4*)(Vt + (8 * db + j) * VT_LD + 8 * sb) = vo[j];
            }
        }
        __syncthreads();
        const int head = kvh * 4 + (wid >> 1);
#pragma unroll 1
        for (int a2 = 0; a2 < 2; ++a2) {
            const int a = 2 * (wid & 1) + a2;
            attn_wave<false>(Ks, Vt, 32 * a, (i == 0) ? 128 : 0, p.Q + ((size_t)b * SEQ + i * 128 + 32 * a) * 1024 + head * 64, p.sinks + head, p.qg, i * 128 + 32 * a, lane);
        }
        __syncthreads();
    }
    constexpr int REG = KS_BYTES + VT_BYTES;
    for (int u = c.bid; u < DECB * 2; u += c.G) {
        const int b = u >> 1, kp = u & 1;
#pragma unroll
        for (int it = 0; it < 5; ++it) {
            const int id = tid + 512 * it;
            const int sel = id / 1280, rem = id % 1280, row = rem >> 3, ch = rem & 7, kvh = 2 * kp + sel;
            LAS bf16_t* Ks2 = (LAS bf16_t*)(lds + sel * REG);
            u32x4 kk = {0u, 0u, 0u, 0u};
            if (row < 128) {
                const size_t so = (((size_t)(p.l * DECB + b) * 128 + row) * 4 + kvh) * 64 + ch * 8;
                const f32x4 k0 = *(const f32x4*)(p.cache_k + so), k1 = *(const f32x4*)(p.cache_k + so + 4);
                kk.x = cvtpk(k0[0], k0[1]); kk.y = cvtpk(k0[2], k0[3]); kk.z = cvtpk(k1[0], k1[1]); kk.w = cvtpk(k1[2], k1[3]);
                if (row >= 8) {
                    float* o = p.out + O_SK + (((size_t)(p.l * DECB + b) * 128 + (row - 8)) * 4 + kvh) * 64 + ch * 8; *(f32x4*)o = k0; *(f32x4*)(o + 4) = k1; }
            } else if (row < 136) {
                kk = *(const u32x4*)(p.KV + ((size_t)MP + b * 8 + (row - 128)) * 512 + kvh * 64 + ch * 8);
            }
            *(LAS u32x4*)(Ks2 + row * KS_LD + ch * 8) = kk;
        }
        if (tid < 320) {
            const int sel = tid / 160, rem = tid % 160, sb = rem % 20, db = rem / 20, kvh = 2 * kp + sel;
            LAS bf16_t* Vt2 = (LAS bf16_t*)(lds + sel * REG + KS_BYTES);
            u32x4 vr[8], vo[8];
            if (sb < 16) {
#pragma unroll
                for (int r8 = 0; r8 < 8; ++r8) {
                    const size_t so = (((size_t)(p.l * DECB + b) * 128 + 8 * sb + r8) * 4 + kvh) * 64 + db * 8;
                    const f32x4 v0 = *(const f32x4*)(p.cache_v + so), v1 = *(const f32x4*)(p.cache_v + so + 4);
                    vr[r8].x = cvtpk(v0[0], v0[1]); vr[r8].y = cvtpk(v0[2], v0[3]); vr[r8].z = cvtpk(v1[0], v1[1]); vr[r8].w = cvtpk(v1[2], v1[3]);
                    if (sb >= 1) { float* o = p.out + O_SV + (((size_t)(p.l * DECB + b) * 128 + (8 * sb + r8 - 8)) * 4 + kvh) * 64 + db * 8; *(f32x4*)o = v0; *(f32x4*)(o + 4) = v1; }
                }
            } else if (sb == 16) {
#pragma unroll
                for (int r8 = 0; r8 < 8; ++r8) vr[r8] = *(const u32x4*)(p.KV + ((size_t)MP + b * 8 + r8) * 512 + 256 + kvh * 64 + db * 8);
            } else {
#pragma unroll
                for (int r8 = 0; r8 < 8; ++r8) vr[r8] = (u32x4){0u, 0u, 0u, 0u};
            }
            transpose8x8(vr, vo);
#pragma unroll
            for (int j = 0; j < 8; ++j) *(LAS u32x4*)(Vt2 + (8 * db + j) * VT_LD + 8 * sb) = vo[j];
        }
        __syncthreads();
        if (wid < 2) {
            const int kvh = 2 * kp + wid;
            attn_wave<true>((const LAS bf16_t*)(lds + wid * REG), (const LAS bf16_t*)(lds + wid * REG + KS_BYTES), 0, 0, p.Q + ((size_t)MP + b * 8) * 1024 + kvh * 256, p.sinks + kvh * 4, p.qg, MP, lane);
        }
        __syncthreads();
    }
}

template <int NOUT>
__device__ __forceinline__ void conv31(const f32x2v (&x)[NOUT + 30], const f32x2v (&w)[31], f32x2v bias, LAS float* dst  ) {
#pragma unroll
    for (int k = 0; k < NOUT; ++k) {
        f32x2v a = bias;
#pragma unroll
        for (int j = 0; j < 31; ++j) a += w[j] * x[k + j];
        *(LAS f32x2v*)(dst + k * 512) = a;
    }
}
__device__ __forceinline__ void phase_conva(const C1P& p, LAS unsigned char* lds, const Ctx& c) {
    const int tid = c.tid, wid = c.wave, lane = c.lane, c2 = tid & 255, h = tid >> 8;
    LAS float* buf = (LAS float*)lds;
    f32x2v w[31];
#pragma unroll
    for (int j = 0; j < 31; ++j) w[j] = *(const f32x2v*)(p.conv_a_w + ((size_t)p.l * 31 + j) * 512 + 2 * c2);
    const f32x2v bias = *(const f32x2v*)(p.conv_a_b + (size_t)p.l * 512 + 2 * c2);
    const f32x4 g0 = *(const f32x4*)(p.ln_a_g + (size_t)p.l * 512 + 8 * lane), g1 = *(const f32x4*)(p.ln_a_g + (size_t)p.l * 512 + 8 * lane + 4);
    const f32x4 b0 = *(const f32x4*)(p.ln_a_b + (size_t)p.l * 512 + 8 * lane), b1 = *(const f32x4*)(p.ln_a_b + (size_t)p.l * 512 + 8 * lane + 4);
    for (int ut = c.bid; ut < M / 64; ut += c.G) {
        const int R0 = 64 * ut;
        if (R0 < MP) {
#pragma unroll 1
            for (int ps = 0; ps < 2; ++ps) {
                const int tb = R0 + 32 * h + 16 * ps, ts = tb & (SEQ - 1);
                f32x2v x[46];
#pragma unroll
                for (int i = 0; i < 46; ++i) {
                    unsigned wv = 0u;
                    if (ts - 30 + i >= 0) wv = *(const unsigned*)(p.GLU + (size_t)(tb - 30 + i) * 512 + 2 * c2);
                    x[i] = (f32x2v){bflo(wv), bfhi(wv)};
                }
                conv31<16>(x, w, bias, buf + (32 * h + 16 * ps) * 512 + 2 * c2);
            }
        } else {
#pragma unroll 1
            for (int sq = 0; sq < 4; ++sq) {
                const int bs = (R0 - MP) / 8 + 4 * h + sq;
                f32x2v x[38];
#pragma unroll
                for (int i = 0; i < 30; ++i) x[i] = *(const f32x2v*)(p.state_a + (((size_t)p.l * DECB + bs) * 30 + i) * 512 + 2 * c2);
#pragma unroll
                for (int i = 0; i < 8; ++i) { const unsigned wv = *(const unsigned*)(p.GLU + ((size_t)MP + bs * 8 + i) * 512 + 2 * c2); x[30 + i] = (f32x2v){bflo(wv), bfhi(wv)}; }
                conv31<8>(x, w, bias, buf + (8 * (4 * h + sq)) * 512 + 2 * c2);
            }
        }
        __syncthreads();
#pragma unroll 4
        for (int k = 0; k < 8; ++k) {
            const int tok = 8 * wid + k;
            f32x4 v0 = *(const LAS f32x4*)(buf + tok * 512 + 8 * lane), v1 = *(const LAS f32x4*)(buf + tok * 512 + 8 * lane + 4);
            const float mean = wave_sum((v0[0] + v0[1]) + (v0[2] + v0[3]) + (v1[0] + v1[1]) + (v1[2] + v1[3])) * (1.f / 512.f);
            v0 -= mean; v1 -= mean;
            const float var = wave_sum((v0[0] * v0[0] + v0[1] * v0[1]) + (v0[2] * v0[2] + v0[3] * v0[3]) + (v1[0] * v1[0] + v1[1] * v1[1]) + (v1[2] * v1[2] + v1[3] * v1[3])) * (1.f / 512.f);
            const float rstd = 1.0f / sqrtf(var + EPS);
            f32x4 o0, o1;
#pragma unroll
            for (int i = 0; i < 4; ++i) { const float y0 = v0[i] * rstd * g0[i] + b0[i], y1 = v1[i] * rstd * g1[i] + b1[i]; o0[i] = y0 * sigm(y0); o1[i] = y1 * sigm(y1); }
            store8(p.AACT + (size_t)(R0 + tok) * 512 + 8 * lane, o0, o1);
        }
        __syncthreads();
    }
}

__device__ __forceinline__ void phase_convb(const C1P& p, const Ctx& c) {
    const long gt = (long)c.gw * 64 + c.lane, NT = (long)c.NGW * 64;
    const int c8 = (int)(gt & 63) * 8;
    f32x4 w0[2], w1[2], w2[2];
#pragma unroll
    for (int hh = 0; hh < 2; ++hh) {
        w0[hh] = *(const f32x4*)(p.conv_b_w + ((size_t)p.l * 3 + 0) * 512 + c8 + 4 * hh);
        w1[hh] = *(const f32x4*)(p.conv_b_w + ((size_t)p.l * 3 + 1) * 512 + c8 + 4 * hh);
        w2[hh] = *(const f32x4*)(p.conv_b_w + ((size_t)p.l * 3 + 2) * 512 + c8 + 4 * hh);
    }
    for (long i = gt; i < (long)(M / 8) * 64; i += NT) {
        const int r0 = (int)(i >> 6) * 8;
        u32x4 xw[10], bw[8];
        f32x4 h0[2], h1[2];
        const bool smp = r0 >= MP, seq0 = (r0 & (SEQ - 1)) == 0;
#pragma unroll
        for (int k = 0; k < 8; ++k) { xw[2 + k] = *(const u32x4*)(p.CGH + (size_t)(r0 + k) * 512 + c8); bw[k] = *(const u32x4*)(p.BG + (size_t)(r0 + k) * 512 + c8); }
        if (smp) {
            const float* st = p.state_b + ((size_t)p.l * DECB + ((r0 - MP) >> 3)) * 2 * 512 + c8;
            h0[0] = *(const f32x4*)st; h0[1] = *(const f32x4*)(st + 4); h1[0] = *(const f32x4*)(st + 512); h1[1] = *(const f32x4*)(st + 512 + 4);
        } else if (!seq0) {
            xw[0] = *(const u32x4*)(p.CGH + (size_t)(r0 - 2) * 512 + c8); xw[1] = *(const u32x4*)(p.CGH + (size_t)(r0 - 1) * 512 + c8);
        }
        f32x4 x[10][2];
#pragma unroll
        for (int k = 2; k < 10; ++k) { x[k][0] = (f32x4){bflo(xw[k].x), bfhi(xw[k].x), bflo(xw[k].y), bfhi(xw[k].y)}; x[k][1] = (f32x4){bflo(xw[k].z), bfhi(xw[k].z), bflo(xw[k].w), bfhi(xw[k].w)}; }
        if (smp) { x[0][0] = h0[0]; x[0][1] = h0[1]; x[1][0] = h1[0]; x[1][1] = h1[1]; }
        else if (!seq0) {
#pragma unroll
            for (int k = 0; k < 2; ++k) { x[k][0] = (f32x4){bflo(xw[k].x), bfhi(xw[k].x), bflo(xw[k].y), bfhi(xw[k].y)}; x[k][1] = (f32x4){bflo(xw[k].z), bfhi(xw[k].z), bflo(xw[k].w), bfhi(xw[k].w)}; }
        } else { const f32x4 z4 = {0.f, 0.f, 0.f, 0.f}; x[0][0] = z4; x[0][1] = z4; x[1][0] = z4; x[1][1] = z4; }
#pragma unroll
        for (int k = 0; k < 8; ++k) {
            const f32x4 bg0 = {bflo(bw[k].x), bfhi(bw[k].x), bflo(bw[k].y), bfhi(bw[k].y)}, bg1 = {bflo(bw[k].z), bfhi(bw[k].z), bflo(bw[k].w), bfhi(bw[k].w)};
            const f32x4 o0 = bg0 * (w0[0] * x[k][0] + w1[0] * x[k + 1][0] + w2[0] * x[k + 2][0]), o1 = bg1 * (w0[1] * x[k][1] + w1[1] * x[k + 1][1] + w2[1] * x[k + 2][1]);
            store8(p.BG + (size_t)(r0 + k) * 512 + c8, o0, o1);
        }
    }
}

constexpr int VVT_LD = 136;
__device__ __forceinline__ void phase_gmlp(const C1P& p, LAS unsigned char* lds, const Ctx& c) {
    const int tid = c.tid, wid = c.wave, lane = c.lane, q = lane & 31, hi = lane >> 5;
    LAS bf16_t* VVt = (LAS bf16_t*)lds;
    for (int u = c.bid; u < 128 * 2; u += c.G) {
        const int ci = u >> 1, hh = u & 1, tok0 = ci * 128;
        {
            const int sb = tid & 15, db = tid >> 4;
            u32x4 vr[8], vo[8];
#pragma unroll
            for (int r8 = 0; r8 < 8; ++r8) vr[r8] = *(const u32x4*)(p.VV + (size_t)(tok0 + 8 * sb + r8) * 512 + 256 * hh + db * 8);
            transpose8x8(vr, vo);
#pragma unroll
            for (int j = 0; j < 8; ++j) *(LAS u32x4*)(VVt + (8 * db + j) * VVT_LD + 8 * sb) = vo[j];
        }
        __syncthreads();
        const int gl = wid >> 1, dt = wid & 1, g = 4 * hh + gl;
        const bf16_t* Wg = p.WSP + ((size_t)(p.l * 8 + g) * 128) * 128;
        const float* bs = p.b_sp + (size_t)(p.l * 8 + g) * 128;
#pragma unroll
        for (int ti = 0; ti < 4; ++ti) {
            f32x16 acc = (f32x16){0.f, 0.f, 0.f, 0.f, 0.f, 0.f, 0.f, 0.f, 0.f, 0.f, 0.f, 0.f, 0.f, 0.f, 0.f, 0.f};
            bf16x8 af[8];
#pragma unroll
            for (int ks = 0; ks < 2 * ti + 2; ++ks) af[ks] = *(const bf16x8*)(Wg + (size_t)(32 * ti + q) * 128 + 16 * ks + 8 * hi);
            bf16_t uu[16]; float bb[16];
#pragma unroll
            for (int r = 0; r < 16; ++r) { const int t = 32 * ti + crow(r, hi); uu[r] = p.U[(size_t)(tok0 + t) * 512 + g * 64 + 32 * dt + q]; bb[r] = bs[t]; }
#pragma unroll
            for (int ks = 0; ks < 2 * ti + 2; ++ks) {
                const bf16x8 bv = *(const LAS bf16x8*)(VVt + (gl * 64 + 32 * dt + q) * VVT_LD + 16 * ks + 8 * hi);
                acc = __builtin_amdgcn_mfma_f32_32x32x16_bf16(af[ks], bv, acc, 0, 0, 0);
            }
#pragma unroll
            for (int r = 0; r < 16; ++r) {
                const int t = 32 * ti + crow(r, hi);
                p.U[(size_t)(tok0 + t) * 512 + g * 64 + 32 * dt + q] = f2bf(bf2f(uu[r]) * (acc[r] + bb[r]));
            }
        }
        __syncthreads();
    }
    const long gt = (long)c.gw * 64 + c.lane, NT = (long)c.NGW * 64;
    for (long i = gt; i < (long)DECB * 512; i += NT) {
        const int b = (int)(i >> 9), ch = (int)(i & 511), g = ch >> 6;
        const float* Wg = p.w_sp + ((size_t)(p.l * 8 + g) * 128) * 128;
        const float* bs = p.b_sp + (size_t)(p.l * 8 + g) * 128;
        float vv[8];
#pragma unroll
        for (int s = 0; s < 8; ++s) vv[s] = bf2f(p.VV[((size_t)MP + b * 8 + s) * 512 + ch]);
#pragma unroll
        for (int t = 0; t < 8; ++t) {
            float z = bs[t];
#pragma unroll
            for (int s = 0; s <= t; ++s) z += Wg[t * 128 + s] * vv[s];
            bf16_t* up = p.U + ((size_t)MP + b * 8 + t) * 512 + ch;
            *up = f2bf(bf2f(*up) * z);
        }
    }
}

#ifndef KMASK
#define KMASK 0xFFFF
#endif
#define KEN(k) ((KMASK >> (k)) & 1)
enum { I_XP = 0, I_XS, I_CP, I_CS, I_STA, I_STB, I_CK, I_CV, I_WADA, I_BADA, I_N1G, I_N2G, I_WIN, I_QNG, I_KNG, I_SINK, I_WAO, I_CAW, I_CAB, I_LAG, I_LAB,
       I_WAOUT, I_CBW, I_WBOUT, I_LCG, I_LCB, I_WSP, I_BSP, I_WCOUT, I_WO, I_WUP, I_WDN };

typedef const __attribute__((address_space(4))) Args* ArgsP;
__device__ __forceinline__ ArgsP get_args() { ArgsP ap = (ArgsP)__builtin_amdgcn_kernarg_segment_ptr(); asm volatile("" : "+s"(ap)); return ap; }
#define WSB(off) ((bf16_t*)(ws + (off)))
__device__ __forceinline__ C1P make_c1p(ArgsP a, int l) {
    unsigned char* ws = a->ws;
    C1P p{WSB(WS_Q), WSB(WS_BG), WSB(WS_U), WSB(WS_AACT), WSB(WS_KV), WSB(WS_GLU), WSB(WS_CGH), WSB(WS_VV), WSB(WS_WSP), a->in[I_SINK] + l * 16, a->in[I_CK], a->in[I_CV], a->in[I_STA], a->in[I_STB],
          a->in[I_CAW], a->in[I_CAB], a->in[I_LAG], a->in[I_LAB], a->in[I_CBW], a->in[I_WSP], a->in[I_BSP], l, a->in[I_QNG] + l * 64, a->out};
    return p;
}

__global__ void __launch_bounds__(NTHR, 2) mega_fwd(Args a_unused) {
    extern __shared__ __attribute__((aligned(16))) unsigned char lds_raw[];
    LAS unsigned char* lds = (LAS unsigned char*)lds_raw;
    cg::grid_group grid = cg::this_grid();
    const int nprog = get_args()->nprog;
    volatile LAS unsigned* MISC = (volatile LAS unsigned*)(lds + BAR_LDS_OFF);
    if (threadIdx.x < 16) MISC[threadIdx.x] = 0u;
    __syncthreads();
    const XcdBarrier bar = xcd_barrier_post((unsigned*)get_args()->ws, MISC);

    for (int pi = 0; pi < nprog; ++pi) {
        const int ph = get_args()->prog[pi];
        const Ctx c = make_ctx();
        LAS float* scr = (LAS float*)(lds + c.wave * 16384);
        const int l = ph < 2 ? 0 : (ph - 2) / 9, kind = ph == 255 ? 99 : (ph < 2 ? ph : 2 + (ph - 2) % 9);
        switch (kind) {
        case 0: if (KEN(0)) {
            ArgsP a = get_args(); unsigned char* ws = a->ws;
            { int tb = 0; for (int ll = 0; ll < NL; ++ll) tb = transpose_tiles(a->in[I_WADA] + (size_t)ll * D * 6144, D, 6144, WSB(WS_WADA), ll * 6144, 0, (LAS float*)lds, tb, c.bid, c.G, c.tid); }
            const long gt = (long)c.gw * 64 + c.lane, NT = (long)c.NGW * 64;
            bf16_t* CS = WSB(WS_CS); bf16_t* WSPB = WSB(WS_WSP);
            const float* cp = a->in[I_CP]; const float* csm = a->in[I_CS]; const float* wsp = a->in[I_WSP];
            for (long i = gt; i < 256 * 1024; i += NT) {
                const int r = (int)(i >> 10), col = (int)(i & 1023);
                float v = 0.f;
                if (r < 2) v = cp[r * D + col]; else if (r < NBROW) v = csm[(size_t)(r - 2) * D + col];
                CS[i] = f2bf(v * sigm(v));
            }
            for (long i = gt; i < (long)NL * 8 * 128 * 128; i += NT) {
                const int t = (int)(i >> 7) & 127, s = (int)i & 127;
                WSPB[i] = f2bf(s <= t ? wsp[i] : 0.f);
            }
        } break;
        case 1: if (KEN(1)) {
            ArgsP a = get_args(); unsigned char* ws = a->ws;
            pg8::Gemm g{WSB(WS_CS), WSB(WS_WADA), 256, MODLD, D, D, D}; pg8::StaticOrder S; S.init(256, MODLD, c.G, c.bid);
            epi::EpiMod E{(float*)(ws + WS_MOD), a->in[I_BADA]};
            pg8::gemm_phase<epi::EpiMod, pg8::StaticOrder, false, true>(lds, g, S, E, c.tid);
            if (c.bid >= 48) {
                int tb = 0; const int b2 = c.bid - 48, G2 = c.G - 48;
                { ArgsP a2 = get_args(); unsigned char* ws = a2->ws; tb = transpose_tiles(a2->in[I_WIN], D, NIN, WSB(WS_WIN), 0, 1, (LAS float*)lds, tb, b2, G2, c.tid); }
                { ArgsP a2 = get_args(); unsigned char* ws = a2->ws; tb = transpose_tiles(a2->in[I_WAO], D, D, WSB(WS_WAO), 0, 0, (LAS float*)lds, tb, b2, G2, c.tid); }
                { ArgsP a2 = get_args(); unsigned char* ws = a2->ws; tb = transpose_tiles(a2->in[I_WAOUT], 512, D, WSB(WS_WA), 0, 0, (LAS float*)lds, tb, b2, G2, c.tid); }
                { ArgsP a2 = get_args(); unsigned char* ws = a2->ws; tb = transpose_tiles(a2->in[I_WBOUT], 512, D, WSB(WS_WB), 0, 0, (LAS float*)lds, tb, b2, G2, c.tid); }
                { ArgsP a2 = get_args(); unsigned char* ws = a2->ws; tb = transpose_tiles(a2->in[I_WCOUT], 512, D, WSB(WS_WC), 0, 0, (LAS float*)lds, tb, b2, G2, c.tid); }
                { ArgsP a2 = get_args(); unsigned char* ws = a2->ws; tb = transpose_tiles(a2->in[I_WO], D, D, WSB(WS_WO), 0, 0, (LAS float*)lds, tb, b2, G2, c.tid); }
            }
        } break;
        case 2: if (KEN(2)) {
            if (l > 0) {
            int tb = 0;
            { ArgsP a = get_args(); unsigned char* ws = a->ws; tb = transpose_tiles(a->in[I_WIN] + (size_t)l * D * NIN, D, NIN, WSB(WS_WIN), 0, 1, (LAS float*)lds, tb, c.bid, c.G, c.tid); }
            { ArgsP a = get_args(); unsigned char* ws = a->ws; tb = transpose_tiles(a->in[I_WAO] + (size_t)l * D * D, D, D, WSB(WS_WAO), 0, 0, (LAS float*)lds, tb, c.bid, c.G, c.tid); }
            { ArgsP a = get_args(); unsigned char* ws = a->ws; tb = transpose_tiles(a->in[I_WAOUT] + (size_t)l * 512 * D, 512, D, WSB(WS_WA), 0, 0, (LAS float*)lds, tb, c.bid, c.G, c.tid); }
            { ArgsP a = get_args(); unsigned char* ws = a->ws; tb = transpose_tiles(a->in[I_WBOUT] + (size_t)l * 512 * D, 512, D, WSB(WS_WB), 0, 0, (LAS float*)lds, tb, c.bid, c.G, c.tid); }
            { ArgsP a = get_args(); unsigned char* ws = a->ws; tb = transpose_tiles(a->in[I_WCOUT] + (size_t)l * 512 * D, 512, D, WSB(WS_WC), 0, 0, (LAS float*)lds, tb, c.bid, c.G, c.tid); }
            { ArgsP a = get_args(); unsigned char* ws = a->ws; tb = transpose_tiles(a->in[I_WO] + (size_t)l * D * D, D, D, WSB(WS_WO), 0, 0, (LAS float*)lds, tb, c.bid, c.G, c.tid); }
            }
            { ArgsP a = get_args(); unsigned char* ws = a->ws; float* X = a->out;
              const float* md = (const float*)(ws + WS_MOD) + (size_t)l * 6144;
              const float* xp = l == 0 ? a->in[I_XP] : X; const float* xs = l == 0 ? a->in[I_XS] : X + (size_t)MP * D;
              adaln_rows(xp, xs, nullptr, WSB(WS_H), a->in[I_N1G] + l * D, md + 0 * D, md + 1 * D, c); }
        } break;
        case 3: if (KEN(3)) {
            ArgsP a = get_args(); unsigned char* ws = a->ws;
            pg8::Gemm g{WSB(WS_H), WSB(WS_WIN), M, NIN, D, D, D}; pg8::StaticOrder S; S.init(M, NIN, c.G, c.bid);
            epi::EpiIn E{WSB(WS_Q), WSB(WS_KV), WSB(WS_GLU), WSB(WS_BG), WSB(WS_CGH), WSB(WS_U), WSB(WS_VV), WSB(WS_G)};
            pg8::gemm_phase<epi::EpiIn, pg8::StaticOrder, true, true>(lds, g, S, E, c.tid);
        } break;
        case 4: if (KEN(4)) {
            ArgsP a = get_args(); unsigned char* ws = a->ws;
            C0P p{WSB(WS_Q), WSB(WS_KV), WSB(WS_VV), WSB(WS_GLU), WSB(WS_CGH), a->in[I_QNG] + l * 64, a->in[I_KNG] + l * 64, a->in[I_LCG] + l * 512, a->in[I_LCB] + l * 512, a->in[I_CK], a->in[I_CV], a->in[I_STA], a->out, l};
            phase_c0(p, c);
        } break;
        case 5: if (KEN(5)) {
#ifndef SMASK
#define SMASK 15
#endif
            if (SMASK & 1) { const Ctx c1 = make_ctx(); const C1P p = make_c1p(get_args(), l); phase_attn(p, lds, c1); }
            if (SMASK & 2) { const Ctx c1 = make_ctx(); const C1P p = make_c1p(get_args(), l); phase_conva(p, lds, c1); }
            if (SMASK & 4) { const Ctx c1 = make_ctx(); const C1P p = make_c1p(get_args(), l); phase_convb(p, c1); }
            if (SMASK & 8) { const Ctx c1 = make_ctx(); const C1P p = make_c1p(get_args(), l); phase_gmlp(p, lds, c1); }
        } break;
        case 6: if (KEN(6)) {
            const bool odd = (blockIdx.x & 1) != 0;
#pragma unroll 1
            for (int st = 0; st < 6; ++st) {
                const Ctx c = make_ctx();
                const int op = !odd ? st : (st == 0 ? 1 : st == 1 ? 0 : st == 5 ? 2 : st + 1);
                ArgsP a = get_args(); unsigned char* ws = a->ws;
                if (op == 0) {
                    pg8::Gemm g{WSB(WS_Q), WSB(WS_WAO), MP, D, D, D, D}; pg8::StaticOrder S; S.init(MP, D, c.G, c.bid);
                    epi::EpiBranch E{WSB(WS_MG), (const unsigned char*)(ws + WS_G), 0};
                    pg8::gemm_phase<epi::EpiBranch, pg8::StaticOrder, true, true>(lds, g, S, E, c.tid);
                } else if (op == 2) {
                    pg8::Gemm g{WSB(WS_AACT), WSB(WS_WA), MP, D, 512, 512, 512};
                    epi::BranchOrder S; S.so.init(MP, D, c.G, c.bid);
                    S.A0 = WSB(WS_AACT); S.A1 = WSB(WS_BG); S.A2 = WSB(WS_U); S.B0 = WSB(WS_WA); S.B1 = WSB(WS_WB); S.B2 = WSB(WS_WC);
                    epi::EpiBranch E{WSB(WS_MG), (const unsigned char*)(ws + WS_G), 1};
                    pg8::gemm_phase<epi::EpiBranch, epi::BranchOrder, true, true>(lds, g, S, E, c.tid);
                } else {
                    const int br = op == 1 ? 0 : op - 2;
                    const bf16_t* A = br == 0 ? WSB(WS_Q) : br == 1 ? WSB(WS_AACT) : br == 2 ? WSB(WS_BG) : WSB(WS_U);
                    const bf16_t* Bt = br == 0 ? WSB(WS_WAO) : br == 1 ? WSB(WS_WA) : br == 2 ? WSB(WS_WB) : WSB(WS_WC);
                    const int K = br == 0 ? 1024 : 512;
                    EpiSBranch ES{WSB(WS_MG), (const unsigned char*)(ws + WS_G) + br * 1024, br == 0 ? 1 : 0};
                    small_gemm(lds, A + (size_t)MP * K, K, Bt, K, K, D, ES, c);
                }
            }
        } break;
        case 7: case 10: if (KEN(7)) {
            const bool dn = kind == 10;
#pragma unroll 1
            for (int st = 0; st < 2; ++st) {
                const Ctx c = make_ctx();
                ArgsP a = get_args(); unsigned char* ws = a->ws;
                const int K = dn ? FF : D;
                const bf16_t* A = dn ? WSB(WS_G) : WSB(WS_MG); const bf16_t* Bt = dn ? WSB(WS_WDN) : WSB(WS_WO);
                const float* gate = (const float*)(ws + WS_MOD) + (size_t)l * 6144 + (dn ? 5 : 2) * D;
                if ((st ^ (c.bid & 1)) == 0) {
                    pg8::Gemm g{A, Bt, MP, D, K, K, K}; pg8::StaticOrder S; S.init(MP, D, c.G, c.bid);
                    epi::EpiRes E{a->out, gate, (!dn && l == 0) ? a->in[I_XP] : (const float*)a->out};
                    pg8::gemm_phase<epi::EpiRes, pg8::StaticOrder, true, true>(lds, g, S, E, c.tid);
                } else {
                    EpiSRes ES{a->out, gate, (!dn && l == 0) ? a->in[I_XS] : (const float*)a->out + (size_t)MP * D};
                    small_gemm(lds, A + (size_t)MP * K, K, Bt, K, K, D, ES, c);
                }
            }
        } break;
        case 8: if (KEN(8)) {
            if (true) {
            int tb = 0;
            { ArgsP a = get_args(); unsigned char* ws = a->ws; tb = transpose_tiles(a->in[I_WUP] + (size_t)l * D * FF, D, FF, WSB(WS_WUP), 0, 0, (LAS float*)lds, tb, c.bid, c.G, c.tid); }
            { ArgsP a = get_args(); unsigned char* ws = a->ws; tb = transpose_tiles(a->in[I_WDN] + (size_t)l * FF * D, FF, D, WSB(WS_WDN), 0, 0, (LAS float*)lds, tb, c.bid, c.G, c.tid); }
            }
            { ArgsP a = get_args(); unsigned char* ws = a->ws; float* X = a->out;
              const float* md = (const float*)(ws + WS_MOD) + (size_t)l * 6144;
              adaln_rows(X, X + (size_t)MP * D, nullptr, WSB(WS_H), a->in[I_N2G] + l * D, md + 3 * D, md + 4 * D, c); }
        } break;
        case 9: if (KEN(9)) {
            ArgsP a = get_args(); unsigned char* ws = a->ws;
            pg8::Gemm g{WSB(WS_H), WSB(WS_WUP), MP, FF, D, D, D}; pg8::StaticOrder S; S.init(MP, FF, c.G, c.bid);
            epi::EpiUp E{WSB(WS_G), FF};
            pg8::gemm_phase<epi::EpiUp, pg8::StaticOrder, true, true>(lds, g, S, E, c.tid);
            EpiSUp ES{WSB(WS_G)};
            small_gemm(lds, WSB(WS_H) + (size_t)MP * D, D, WSB(WS_WUP), D, D, FF, ES, c);
        } break;
        default: break;
        }
        if (pi + 1 < nprog) { if (nprog > 200) grid.sync(); xcd_barrier(bar); }
    }
}

constexpr int NPHASES = 2 + 9 * NL;

extern "C" void kernel_launch(void* const* d_in, const int* in_sizes, int n_in, void* d_out, int out_size, void* d_ws, size_t ws_size, hipStream_t stream) {
    static int grid = 0;
    if (grid == 0) {
        if (n_in != 32 || ws_size < WS_END) { fprintf(stderr, "kernel_launch: unexpected n_in %d / ws_size %zu (need %zu)\n", n_in, ws_size, (size_t)WS_END); grid = -1; return; }
        int dev = 0, cus = 0, per_cu = 0;
        hipGetDevice(&dev); hipDeviceGetAttribute(&cus, hipDeviceAttributeMultiprocessorCount, dev);
        hipFuncSetAttribute((const void*)mega_fwd, hipFuncAttributeMaxDynamicSharedMemorySize, LDS_BYTES);
        hipOccupancyMaxActiveBlocksPerMultiprocessor(&per_cu, (const void*)mega_fwd, NTHR, LDS_BYTES);
        (void)hipGetLastError();
        if (per_cu < 1) per_cu = 1;
        grid = cus * per_cu;
    }
    if (grid < 0) return;
    Args a{};
    for (int i = 0; i < 32; ++i) a.in[i] = (const float*)d_in[i];
    a.out = (float*)d_out; a.ws = (unsigned char*)d_ws;
    int n = 0;
#ifndef PROBE
#define PROBE 0
#endif
    for (int ph = 0; ph < NPHASES; ++ph) {
        const int k = ph < 2 ? ph : 2 + (ph - 2) % 9;
        a.prog[n++] = (unsigned char)ph;
        if (PROBE == 1 && (k == 3 || k == 6 || k == 9)) a.prog[n++] = (unsigned char)ph;
        if (PROBE == 2 && (k == 2 || k == 8)) a.prog[n++] = (unsigned char)ph;
        if (PROBE == 2 && k == 1) { a.prog[n++] = 0; a.prog[n++] = 1; }
        if (PROBE == 3 && k == 5) { a.prog[n++] = (unsigned char)(ph - 3); a.prog[n++] = (unsigned char)(ph - 2); a.prog[n++] = (unsigned char)(ph - 1); a.prog[n++] = (unsigned char)ph; }
        if (PROBE == 4) a.prog[n++] = 255;
    }
    a.nprog = n;
    (void)hipMemsetAsync(d_ws, 0, BAR_BYTES, stream);
    void* args[] = {&a};
    hipError_t e = hipLaunchCooperativeKernel((const void*)mega_fwd, dim3(grid), dim3(NTHR), args, LDS_BYTES, stream);
    if (e != hipSuccess) fprintf(stderr, "cooperative launch failed: %s (grid %d)\n", hipGetErrorString(e), grid);
}
```

```cpp
#include <hip/hip_runtime.h>
#include <hip/hip_cooperative_groups.h>
#include <cstdio>
#include <cstdint>
namespace cg = cooperative_groups;
namespace pg8 {
#define PG8_LAS __attribute__((address_space(3)))
typedef unsigned short bf16_t;
typedef short bf16x8 __attribute__((ext_vector_type(8)));
typedef float f32x4 __attribute__((ext_vector_type(4)));
typedef unsigned u32x4 __attribute__((ext_vector_type(4)));
constexpr int BM = 256, BK = 64, HALF = 128, HTB = HALF * BK * 2  , STAGE_BYTES = 8 * HTB, NXCD = 8, WGM = 8;

__host__ __device__ __forceinline__ int lds_byte(int r, int c) { const int st = (r >> 4) * 2 + (c >> 5), rr = r & 15, cc = c & 31, ob = rr * 64 + cc * 2; return st * 1024 + (ob ^ (((ob >> 9) & 1) << 5)); }
__host__ __device__ __forceinline__ void stage_rc(int b, int& R, int& C) { const int st = b / 1024, sb = b % 1024, swz = sb ^ (((sb >> 9) & 1) << 5); R = (st >> 1) * 16 + swz / 64; C = (st & 1) * 32 + (swz % 64) / 2; }
__host__ __device__ __forceinline__ int perm32(int rho) { const int n = rho >> 4, i = rho & 15; return 8 * (i >> 2) + 4 * n + (i & 3); }

struct Unit { int pm, pn, aux; };
struct Gemm { const bf16_t* A; const bf16_t* Bt; int M, N, K, lda, ldb; };

struct StaticOrder {
    int nM, nN, nwg, G, c;
    __host__ __device__ void init(int M, int N, int G_, int c_) { nM = M / BM; nN = N / BM; nwg = nM * nN; G = G_; c = c_; }
    __host__ __device__ bool next(int i, Unit& u) const {
        const long L = (long)i * G + c; if (L >= nwg) return false;
        int wgid = (int)L; { const int q = nwg / NXCD, r = nwg % NXCD, xcd = wgid % NXCD, off = wgid / NXCD; wgid = (xcd < r ? xcd * (q + 1) : r * (q + 1) + (xcd - r) * q) + off; }
        const int nig = WGM * nN, gid = wgid / nig, fm = gid * WGM, gsz = (nM - fm) < WGM ? (nM - fm) : WGM;
        u.pm = fm + ((wgid % nig) % gsz); u.pn = (wgid % nig) / gsz; u.aux = 0; return true;
    }
    template <class G_> __device__ __forceinline__ const bf16_t* opA(const Unit&, const G_& g) const { return g.A; }
    template <class G_> __device__ __forceinline__ const bf16_t* opB(const Unit&, const G_& g) const { return g.Bt; }
    __device__ __forceinline__ void a_ready(const Unit&) const {}
    __device__ __forceinline__ void done(const Unit&) const {}
};
__device__ __forceinline__ unsigned cvt_pk_bf16(float lo, float hi) { unsigned r; asm volatile("v_cvt_pk_bf16_f32 %0, %1, %2" : "=v"(r) : "v"(lo), "v"(hi)); return r; }
typedef float f32x2 __attribute__((ext_vector_type(2)));
template <class Epi, class Sched, bool ALIGN_EPI = false, bool SP2 = false>
__device__ __forceinline__ void gemm_phase(PG8_LAS unsigned char* lds, const Gemm g, const Sched& S, const Epi& E, const int tid) {
    const int wid = __builtin_amdgcn_readfirstlane(tid >> 6), lane = tid & 63, wr = wid >> 2, wc = wid & 3, fr = lane & 15, fq = lane >> 4;
    const int K = g.K, nt = K / BK;
    unsigned voffA[2], voffB[2];
#pragma unroll
    for (int i = 0; i < 2; ++i) { int R, C; stage_rc(tid * 16 + i * 8192, R, C); const int Rb = Epi::PERM ? ((R & ~31) + perm32(R & 31)) : R;
        voffA[i] = (unsigned)(R * g.lda + C) * 2u; voffB[i] = (unsigned)(Rb * g.ldb + C) * 2u; }
    const size_t kstep = (size_t)(BK * 2);
    const size_t hstepA = (size_t)HALF * g.lda * 2, hstepB = (size_t)HALF * g.ldb * 2;
    const size_t tstepA = 2 * hstepA, tstepB = 2 * hstepB;
    const unsigned ldsw = (unsigned)wid * 1024u;
    const int aoff = lds_byte(wr * 64 + fr, fq * 8), boff = lds_byte(wc * 32 + fr, fq * 8);
#define PG8_SA(b, h) (((b) * 2 + (h)) * HTB)
#define PG8_SB(b, h) ((4 + (b) * 2 + (h)) * HTB)
#define PG8_STAGE(bufoff, gbase, voff) do { _Pragma("unroll") for (int _i = 0; _i < 2; ++_i) \
        __builtin_amdgcn_global_load_lds((const unsigned*)((const char*)(gbase) + (voff)[_i]), (PG8_LAS unsigned*)(lds + (bufoff) + ldsw + _i * 8192), 16, 0, 0); } while (0)
#define PG8_LDA(dst, b, h) do { _Pragma("unroll") for (int m = 0; m < 4; ++m) _Pragma("unroll") for (int k = 0; k < 2; ++k) dst[m][k] = *(const PG8_LAS bf16x8*)(lds + PG8_SA(b, h) + aoff + m * 2048 + k * 1024); } while (0)
#define PG8_LDB(dst, b, h) do { _Pragma("unroll") for (int n = 0; n < 2; ++n) _Pragma("unroll") for (int k = 0; k < 2; ++k) dst[n][k] = *(const PG8_LAS bf16x8*)(lds + PG8_SB(b, h) + boff + n * 2048 + k * 1024); } while (0)
#define PG8_MMA(ai, bj, At, Bt) do { __builtin_amdgcn_s_setprio(1); _Pragma("unroll") for (int m = 0; m < 4; ++m) _Pragma("unroll") for (int n = 0; n < 2; ++n) _Pragma("unroll") for (int k = 0; k < 2; ++k) \
        acc[ai][bj][m][n] = __builtin_amdgcn_mfma_f32_16x16x32_bf16(Bt[n][k], At[m][k], acc[ai][bj][m][n], 0, 0, 0); __builtin_amdgcn_s_setprio(0); } while (0)
#define PG8_WAIT_V(n) asm volatile("s_waitcnt vmcnt(" #n ")" ::: "memory")
#define PG8_WAIT_L(n) asm volatile("s_waitcnt lgkmcnt(" #n ")" ::: "memory")
#define PG8_BAR __builtin_amdgcn_s_barrier()
#define PG8_SCHED __builtin_amdgcn_sched_barrier(0)
    Unit cur, nxt; int ui = 0;
    if (!S.next(0, cur)) return;
    f32x4 acc[2][2][4][2];
#pragma unroll
    for (int a = 0; a < 2; ++a)
#pragma unroll
        for (int b = 0; b < 2; ++b)
#pragma unroll
            for (int m = 0; m < 4; ++m)
#pragma unroll
                for (int n = 0; n < 2; ++n) acc[a][b][m][n] = (f32x4){0.f, 0.f, 0.f, 0.f};
    bf16x8 At[4][2], B0[2][2], B1[2][2];
    const char* cA = (const char*)S.opA(cur, g) + (size_t)cur.pm * tstepA; const char* cB = (const char*)S.opB(cur, g) + (size_t)cur.pn * tstepB;
    S.a_ready(cur);
    if constexpr (SP2) {
        PG8_STAGE(PG8_SB(0, 0), cB, voffB); PG8_STAGE(PG8_SB(0, 1), cB + hstepB, voffB); PG8_STAGE(PG8_SA(0, 0), cA, voffA); PG8_STAGE(PG8_SA(0, 1), cA + hstepA, voffA);
        if (wr == 1) PG8_BAR;
        PG8_WAIT_V(2); PG8_BAR;
        PG8_STAGE(PG8_SB(1, 0), cB + kstep, voffB); PG8_STAGE(PG8_SA(1, 0), cA + kstep, voffA); PG8_STAGE(PG8_SB(1, 1), cB + hstepB + kstep, voffB);
        PG8_WAIT_V(6); PG8_BAR;
    } else {
        PG8_STAGE(PG8_SB(0, 0), cB, voffB); PG8_STAGE(PG8_SA(0, 0), cA, voffA); PG8_STAGE(PG8_SB(0, 1), cB + hstepB, voffB); PG8_STAGE(PG8_SA(0, 1), cA + hstepA, voffA);
        if (wr == 1) PG8_BAR;
        PG8_WAIT_V(4); PG8_BAR;
        PG8_STAGE(PG8_SB(1, 0), cB + kstep, voffB); PG8_STAGE(PG8_SA(1, 0), cA + kstep, voffA); PG8_STAGE(PG8_SB(1, 1), cB + hstepB + kstep, voffB);
        PG8_WAIT_V(6); PG8_BAR;
    }
    for (;;) {
        const bool has_next = S.next(ui + 1, nxt);
        const char* nA = has_next ? (const char*)S.opA(nxt, g) + (size_t)nxt.pm * tstepA : cA; const char* nB = has_next ? (const char*)S.opB(nxt, g) + (size_t)nxt.pn * tstepB : cB;
        for (int t = 0; t < nt; t += 2) {
            const bool last = (t == nt - 2);
            const char* a1 = cA + (size_t)(t + 1) * kstep;
            const char* a2 = last ? nA : cA + (size_t)(t + 2) * kstep; const char* b2 = last ? nB : cB + (size_t)(t + 2) * kstep;
            const char* a3 = a2 + kstep; const char* b3 = b2 + kstep;
            if (last && has_next) S.a_ready(nxt);
            if constexpr (SP2) {
            PG8_LDB(B0, 0, 0); PG8_LDB(B1, 0, 1); PG8_SCHED; PG8_LDA(At, 0, 0); PG8_STAGE(PG8_SA(1, 1), a1 + hstepA, voffA);
            PG8_WAIT_V(8); PG8_WAIT_L(0); PG8_BAR; PG8_MMA(0, 0, At, B0); PG8_MMA(0, 1, At, B1); PG8_BAR; PG8_SCHED;
            PG8_LDA(At, 0, 1); PG8_STAGE(PG8_SB(0, 0), b2, voffB); PG8_STAGE(PG8_SB(0, 1), b2 + hstepB, voffB); PG8_STAGE(PG8_SA(0, 0), a2, voffA);
            PG8_WAIT_V(8); PG8_WAIT_L(0); PG8_BAR; PG8_MMA(1, 0, At, B0); PG8_MMA(1, 1, At, B1); PG8_BAR; PG8_SCHED;
            PG8_LDB(B0, 1, 0); PG8_LDB(B1, 1, 1); PG8_SCHED; PG8_LDA(At, 1, 0); PG8_STAGE(PG8_SA(0, 1), a2 + hstepA, voffA);
            PG8_WAIT_V(8); PG8_WAIT_L(0); PG8_BAR; PG8_MMA(0, 0, At, B0); PG8_MMA(0, 1, At, B1); PG8_BAR; PG8_SCHED;
            PG8_LDA(At, 1, 1); PG8_STAGE(PG8_SB(1, 0), b3, voffB); PG8_STAGE(PG8_SB(1, 1), b3 + hstepB, voffB); PG8_STAGE(PG8_SA(1, 0), a3, voffA);
            PG8_WAIT_V(8); PG8_WAIT_L(0); PG8_BAR; PG8_MMA(1, 0, At, B0); PG8_MMA(1, 1, At, B1); PG8_BAR; PG8_SCHED;
            } else {
            PG8_LDB(B0, 0, 0); PG8_SCHED; PG8_LDA(At, 0, 0); PG8_STAGE(PG8_SA(1, 1), a1 + hstepA, voffA);
            PG8_WAIT_L(8); PG8_BAR; PG8_WAIT_L(0); PG8_MMA(0, 0, At, B0); PG8_BAR; PG8_SCHED;
            PG8_LDB(B1, 0, 1); PG8_STAGE(PG8_SB(0, 0), b2, voffB);
            PG8_BAR; PG8_WAIT_L(0); PG8_MMA(0, 1, At, B1); PG8_BAR;
            PG8_LDA(At, 0, 1); PG8_STAGE(PG8_SA(0, 0), a2, voffA);
            PG8_BAR; PG8_WAIT_L(0); PG8_MMA(1, 0, At, B0); PG8_BAR; PG8_SCHED;
            PG8_STAGE(PG8_SB(0, 1), b2 + hstepB, voffB);
            PG8_WAIT_V(6); PG8_BAR; PG8_MMA(1, 1, At, B1); PG8_BAR;
            PG8_LDB(B0, 1, 0); PG8_SCHED; PG8_LDA(At, 1, 0); PG8_STAGE(PG8_SA(0, 1), a2 + hstepA, voffA);
            PG8_WAIT_L(8); PG8_BAR; PG8_WAIT_L(0); PG8_MMA(0, 0, At, B0); PG8_BAR; PG8_SCHED;
            PG8_LDB(B1, 1, 1); PG8_STAGE(PG8_SB(1, 0), b3, voffB);
            PG8_BAR; PG8_WAIT_L(0); PG8_MMA(0, 1, At, B1); PG8_BAR;
            PG8_LDA(At, 1, 1); PG8_STAGE(PG8_SA(1, 0), a3, voffA);
            PG8_BAR; PG8_WAIT_L(0); PG8_MMA(1, 0, At, B0); PG8_BAR; PG8_SCHED;
            PG8_STAGE(PG8_SB(1, 1), b3 + hstepB, voffB);
            PG8_WAIT_V(6); PG8_BAR; PG8_MMA(1, 1, At, B1); PG8_BAR;
            }
        }
        if constexpr (ALIGN_EPI) { if (wr == 0) PG8_BAR; }
        if constexpr (!Epi::AFTER_DRAIN) { E(acc, cur, wr, wc, fr, fq); S.done(cur); }
        if (!has_next) break;
#pragma unroll
        for (int a = 0; a < 2; ++a)
#pragma unroll
            for (int b = 0; b < 2; ++b)
#pragma unroll
                for (int m = 0; m < 4; ++m)
#pragma unroll
                    for (int n = 0; n < 2; ++n) acc[a][b][m][n] = (f32x4){0.f, 0.f, 0.f, 0.f};
        cur = nxt; cA = nA; cB = nB; ++ui;
        if constexpr (ALIGN_EPI) { if (wr == 1) PG8_BAR; }
    }
    PG8_WAIT_V(0);
    if constexpr (!ALIGN_EPI) { if (wr == 0) PG8_BAR; }
    PG8_BAR;
    if constexpr (Epi::AFTER_DRAIN) { E.fused(acc, cur, wr, wc, fr, fq, lds, wid, lane); S.done(cur); }
#undef PG8_SA
#undef PG8_SB
#undef PG8_STAGE
#undef PG8_LDA
#undef PG8_LDB
#undef PG8_MMA
#undef PG8_WAIT_V
#undef PG8_WAIT_L
#undef PG8_BAR
#undef PG8_SCHED
}
}

#define LAS __attribute__((address_space(3)))
typedef pg8::bf16_t bf16_t;
typedef pg8::bf16x8 bf16x8;
typedef pg8::f32x4 f32x4;
typedef pg8::u32x4 u32x4;
typedef float f32x16 __attribute__((ext_vector_type(16)));
typedef float f32x2v __attribute__((ext_vector_type(2)));
typedef unsigned u32x2 __attribute__((ext_vector_type(2)));
typedef short s16x4 __attribute__((ext_vector_type(4)));

constexpr int D = 1024, SEQ = 8192, MP = 16384, MS = 1024, M = MP + MS, NL = 2, DECB = 128, DECT = 8;
constexpr int NIN = 9216, FF = 4096, NBROW = 130, MODLD = 12288;
constexpr float EPS = 1e-6f;
constexpr int NWAVES = 8, NTHR = 512;
constexpr int LDS_BYTES = 147456, BAR_LDS_OFF = 147456 - 256;
constexpr size_t BAR_BYTES = 16384;

constexpr size_t MiB = 1u << 20;
constexpr size_t WS_WIN = 1 * MiB, WS_WAO = 19 * MiB, WS_WA = 21 * MiB, WS_WB = 22 * MiB, WS_WC = 23 * MiB, WS_WO = 24 * MiB, WS_WSP = 26 * MiB;
constexpr size_t WS_MOD = 27 * MiB, WS_H = 39 * MiB, WS_G = 73 * MiB, WS_R1 = 209 * MiB;
constexpr size_t WS_Q = WS_R1, WS_KV = WS_Q + 34 * MiB, WS_GLU = WS_KV + 17 * MiB, WS_CGH = WS_GLU + 17 * MiB, WS_VV = WS_CGH + 17 * MiB, WS_BG = WS_VV + 17 * MiB, WS_U = WS_BG + 17 * MiB;
constexpr size_t WS_WUP = WS_U + 17 * MiB, WS_WDN = WS_WUP + 8 * MiB;
constexpr size_t WS_END = WS_WDN + 8 * MiB;
constexpr size_t WS_WADA = WS_G, WS_CS = WS_R1, WS_AACT = WS_H, WS_MG = WS_KV;

constexpr size_t O_PA = 17825792, O_SA = 17887232, O_PB = 21819392, O_SB = 21823488, O_PK = 22085632, O_SK = 22216704, O_PV = 30605312, O_SV = 30736384, O_SG = 39124992;

__device__ __forceinline__ unsigned cvtpk(float lo, float hi) { return pg8::cvt_pk_bf16(lo, hi); }
__device__ __forceinline__ float bflo(unsigned w) { return __uint_as_float(w << 16); }
__device__ __forceinline__ float bfhi(unsigned w) { return __uint_as_float(w & 0xffff0000u); }
__device__ __forceinline__ float bf2f(bf16_t h) { return __uint_as_float((unsigned)h << 16); }
__device__ __forceinline__ bf16_t f2bf(float f) { return (bf16_t)(cvtpk(f, 0.f) & 0xffffu); }
__device__ __forceinline__ float sigm(float x) { return __builtin_amdgcn_rcpf(1.f + __builtin_amdgcn_exp2f(-1.4426950408889634f * x)); }
__device__ __forceinline__ float gelu_t(float x) { const float u = 1.5957691216057308f * (x + 0.044715f * x * x * x); return x * sigm(u); }
__device__ __forceinline__ float wave_sum(float v) {
#pragma unroll
    for (int o = 1; o < 64; o <<= 1) v += __shfl_xor(v, o);
    return v;
}
__device__ __forceinline__ int bidx(int r) { return r < MP ? (r >> 13) : 2 + ((r - MP) >> 3); }
__device__ __forceinline__ int crow(int r, int hi) { return (r & 3) + 8 * (r >> 2) + 4 * hi; }
__device__ __forceinline__ void store8(bf16_t* p, f32x4 a, f32x4 b) {
    u32x4 w; w.x = cvtpk(a[0], a[1]); w.y = cvtpk(a[2], a[3]); w.z = cvtpk(b[0], b[1]); w.w = cvtpk(b[2], b[3]); *(u32x4*)p = w;
}

__device__ __forceinline__ unsigned q8(float s) { return (unsigned)(s * 255.f + 0.5f); }
__device__ __forceinline__ unsigned pack4_q8(float a, float b, float c, float d) { return q8(a) | (q8(b) << 8) | (q8(c) << 16) | (q8(d) << 24); }
__device__ __forceinline__ float ub(unsigned w, int k) { return (float)((w >> (8 * k)) & 0xffu) * (1.f / 255.f); }
namespace epi {
using namespace pg8;
struct BranchOrder {
    StaticOrder so; const bf16_t *A0, *A1, *A2, *B0, *B1, *B2;
    __device__ __forceinline__ bool next(int i, Unit& u) const { if (i >= 3) return false; Unit t; if (!so.next(0, t)) return false; u.pm = t.pm; u.pn = t.pn; u.aux = i; return true; }
    template <class G_> __device__ __forceinline__ const bf16_t* opA(const Unit& u, const G_&) const { return u.aux == 0 ? A0 : u.aux == 1 ? A1 : A2; }
    template <class G_> __device__ __forceinline__ const bf16_t* opB(const Unit& u, const G_&) const { return u.aux == 0 ? B0 : u.aux == 1 ? B1 : B2; }
    __device__ __forceinline__ void a_ready(const Unit&) const {}
    __device__ __forceinline__ void done(const Unit&) const {}
};
struct EpiIn {
    static constexpr bool PERM = true, AFTER_DRAIN = false;
    bf16_t *Q, *KV, *GLU, *BG, *CGH, *U, *VV, *G;
    __device__ __forceinline__ void operator()(const f32x4 (&acc)[2][2][4][2], const Unit& u, int wr, int wc, int fr, int fq) const {
        const int pn = u.pn;
        bf16_t* dst; int ld, c0, act = 0, pair = 0;
        if (pn < 4) { dst = Q; ld = 1024; c0 = 256 * pn; }
        else if (pn < 6) { dst = KV; ld = 512; c0 = 256 * (pn - 4); }
        else if (pn < 10) { dst = GLU; ld = 512; c0 = 128 * (pn - 6); pair = 1; }
        else if (pn < 12) { dst = BG; ld = 512; c0 = 256 * (pn - 10); }
        else if (pn < 16) { dst = CGH; ld = 512; c0 = 128 * (pn - 12); pair = 2; }
        else if (pn < 18) { dst = U; ld = 512; c0 = 256 * (pn - 16); act = 2; }
        else if (pn < 20) { dst = VV; ld = 512; c0 = 256 * (pn - 18); act = 2; }
        else { dst = G; ld = 4096; c0 = 256 * (pn - 20); act = 3; }
        const int row0 = u.pm * BM + wr * 64 + fr, col0 = c0 + wc * 32 + 8 * fq;
#pragma unroll
        for (int ai = 0; ai < 2; ++ai)
#pragma unroll
            for (int m = 0; m < 4; ++m) {
                bf16_t* rowp = dst + (size_t)(row0 + ai * HALF + m * 16) * ld + col0;
                if (pair) {
                    f32x4 a0 = acc[ai][0][m][0], a1 = acc[ai][0][m][1], g0 = acc[ai][1][m][0], g1 = acc[ai][1][m][1];
                    if (pair == 1) {
#pragma unroll
                        for (int i = 0; i < 4; ++i) { g0[i] = sigm(g0[i]); g1[i] = sigm(g1[i]); }
                    }
                    store8(rowp, a0 * g0, a1 * g1);
                } else {
#pragma unroll
                    for (int bj = 0; bj < 2; ++bj) {
                        f32x4 v0 = acc[ai][bj][m][0], v1 = acc[ai][bj][m][1];
                        if (act == 3) {
#pragma unroll
                            for (int i = 0; i < 4; ++i) { v0[i] = sigm(v0[i]); v1[i] = sigm(v1[i]); }
                            u32x2 w; w.x = pack4_q8(v0[0], v0[1], v0[2], v0[3]); w.y = pack4_q8(v1[0], v1[1], v1[2], v1[3]);
                            *(u32x2*)((unsigned char*)dst + (size_t)(row0 + ai * HALF + m * 16) * 4096 + col0 + bj * HALF) = w;
                            continue;
                        } else if (act == 2) {
#pragma unroll
                            for (int i = 0; i < 4; ++i) { v0[i] = gelu_t(v0[i]); v1[i] = gelu_t(v1[i]); }
                        }
                        store8(rowp + bj * HALF, v0, v1);
                    }
                }
            }
    }
};
struct EpiUp {
    static constexpr bool PERM = true, AFTER_DRAIN = false;
    bf16_t* O; int ld;
    __device__ __forceinline__ void operator()(const f32x4 (&acc)[2][2][4][2], const Unit& u, int wr, int wc, int fr, int fq) const {
        const int row0 = u.pm * BM + wr * 64 + fr, col0 = u.pn * BM + wc * 32 + 8 * fq;
#pragma unroll
        for (int ai = 0; ai < 2; ++ai)
#pragma unroll
            for (int m = 0; m < 4; ++m) {
                bf16_t* rowp = O + (size_t)(row0 + ai * HALF + m * 16) * ld + col0;
#pragma unroll
                for (int bj = 0; bj < 2; ++bj) {
                    f32x4 v0 = acc[ai][bj][m][0], v1 = acc[ai][bj][m][1];
#pragma unroll
                    for (int i = 0; i < 4; ++i) { const float a = fmaxf(v0[i], 0.f), b = fmaxf(v1[i], 0.f); v0[i] = a * a; v1[i] = b * b; }
                    store8(rowp + bj * HALF, v0, v1);
                }
            }
    }
};
struct EpiBranch {
    static constexpr bool PERM = true, AFTER_DRAIN = false;
    bf16_t* MG; const unsigned char* Gb; int br0;
    __device__ __forceinline__ void operator()(const f32x4 (&acc)[2][2][4][2], const Unit& u, int wr, int wc, int fr, int fq) const {
        const int row0 = u.pm * BM + wr * 64 + fr, col0 = u.pn * BM + wc * 32 + 8 * fq;
        const int br = br0 + u.aux; const bool first = br == 0; const unsigned char* Gt = Gb + br * 1024;
        u32x2 gw[2][4][2];
#pragma unroll
        for (int ai = 0; ai < 2; ++ai)
#pragma unroll
            for (int m = 0; m < 4; ++m)
#pragma unroll
                for (int bj = 0; bj < 2; ++bj) gw[ai][m][bj] = *(const u32x2*)(Gt + (size_t)(row0 + ai * HALF + m * 16) * 4096 + col0 + bj * HALF);
#pragma unroll
        for (int ai = 0; ai < 2; ++ai) {
            u32x4 mw[4][2];
#pragma unroll
            for (int m = 0; m < 4; ++m)
#pragma unroll
                for (int bj = 0; bj < 2; ++bj) {
                    const size_t r = (size_t)(row0 + ai * HALF + m * 16); const int c = col0 + bj * HALF;
                    if (!first) mw[m][bj] = *(const u32x4*)(MG + r * 1024 + c); else mw[m][bj] = (u32x4){0u, 0u, 0u, 0u};
                }
#pragma unroll
            for (int m = 0; m < 4; ++m)
#pragma unroll
                for (int bj = 0; bj < 2; ++bj) {
                    const size_t r = (size_t)(row0 + ai * HALF + m * 16); const int c = col0 + bj * HALF;
                    const u32x2 g = gw[ai][m][bj]; const u32x4 o = mw[m][bj];
                    f32x4 v0 = acc[ai][bj][m][0], v1 = acc[ai][bj][m][1];
                    v0[0] = v0[0] * ub(g.x, 0) + bflo(o.x); v0[1] = v0[1] * ub(g.x, 1) + bfhi(o.x); v0[2] = v0[2] * ub(g.x, 2) + bflo(o.y); v0[3] = v0[3] * ub(g.x, 3) + bfhi(o.y);
                    v1[0] = v1[0] * ub(g.y, 0) + bflo(o.z); v1[1] = v1[1] * ub(g.y, 1) + bfhi(o.z); v1[2] = v1[2] * ub(g.y, 2) + bflo(o.w); v1[3] = v1[3] * ub(g.y, 3) + bfhi(o.w);
                    store8(MG + r * 1024 + c, v0, v1);
                }
        }
    }
};
struct EpiRes {
    static constexpr bool PERM = false, AFTER_DRAIN = false;
    float* X; const float* gate; const float* base;
    __device__ __forceinline__ void operator()(const f32x4 (&acc)[2][2][4][2], const Unit& u, int wr, int wc, int fr, int fq) const {
        const int row0 = u.pm * BM + wr * 64 + fr, col0 = u.pn * BM + wc * 32 + 4 * fq;
        const float* gp = gate + (size_t)bidx(u.pm * BM) * MODLD + col0;
        f32x4 g[2][2];
#pragma unroll
        for (int bj = 0; bj < 2; ++bj)
#pragma unroll
            for (int n = 0; n < 2; ++n) g[bj][n] = *(const f32x4*)(gp + bj * HALF + n * 16);
#pragma unroll
        for (int ai = 0; ai < 2; ++ai) {
            f32x4 x[4][2][2];
#pragma unroll
            for (int m = 0; m < 4; ++m)
#pragma unroll
                for (int bj = 0; bj < 2; ++bj)
#pragma unroll
                    for (int n = 0; n < 2; ++n) x[m][bj][n] = *(const f32x4*)(base + (size_t)(row0 + ai * HALF + m * 16) * 1024 + col0 + bj * HALF + n * 16);
#pragma unroll
            for (int m = 0; m < 4; ++m)
#pragma unroll
                for (int bj = 0; bj < 2; ++bj)
#pragma unroll
                    for (int n = 0; n < 2; ++n)
                        *(f32x4*)(X + (size_t)(row0 + ai * HALF + m * 16) * 1024 + col0 + bj * HALF + n * 16) = x[m][bj][n] + g[bj][n] * acc[ai][bj][m][n];
        }
    }
};
struct EpiMod {
    static constexpr bool PERM = false, AFTER_DRAIN = false;
    float* O; const float* bias;
    __device__ __forceinline__ void operator()(const f32x4 (&acc)[2][2][4][2], const Unit& u, int wr, int wc, int fr, int fq) const {
        const int row0 = u.pm * BM + wr * 64 + fr, col0 = u.pn * BM + wc * 32 + 4 * fq;
#pragma unroll
        for (int ai = 0; ai < 2; ++ai)
#pragma unroll
            for (int m = 0; m < 4; ++m) {
                const int r = row0 + ai * HALF + m * 16;
                if (r < NBROW) {
#pragma unroll
                    for (int bj = 0; bj < 2; ++bj)
#pragma unroll
                        for (int n = 0; n < 2; ++n) {
                            const int c = col0 + bj * HALF + n * 16;
                            *(f32x4*)(O + (size_t)r * MODLD + c) = acc[ai][bj][m][n] + *(const f32x4*)(bias + c);
                        }
                }
            }
    }
};
}


#define RLX_AGENT __ATOMIC_RELAXED, __HIP_MEMORY_SCOPE_AGENT
#define LDS_WAIT() asm volatile("s_waitcnt lgkmcnt(0)" ::: "memory")
#define VM_WAIT() asm volatile("s_waitcnt vmcnt(0)" ::: "memory")
__device__ __forceinline__ unsigned long long rt() { return __builtin_amdgcn_s_memrealtime(); }
#define XB_TMO      128
#define XB_XCNT(j)  (256  + 64 * (j))
#define XB_XSUB(j)  (1280 + 64 * (j))
#define XB_XGEN(j)  (2304 + 64 * (j))
#define XB_TOP      3328
#define XB_TOPGEN   3392
#define XCD_BAR_WORDS 3456
#define XB_SPIN_CAP (1u << 18)

__device__ __forceinline__ unsigned xb_ld(unsigned* p)              { return __hip_atomic_load(p, __ATOMIC_RELAXED, __HIP_MEMORY_SCOPE_AGENT); }
__device__ __forceinline__ unsigned xb_add(unsigned* p, unsigned v) { return __hip_atomic_fetch_add(p, v, __ATOMIC_RELAXED, __HIP_MEMORY_SCOPE_AGENT); }
__device__ __forceinline__ unsigned xb_xcc_id() { return (unsigned)__builtin_amdgcn_s_getreg((3 << 11) | 20) & 0xFu; }
#define XB_SPIN(cond, bar) do { unsigned _sp = 0; while (cond) { __builtin_amdgcn_s_sleep(1); \
    if ((++_sp & 255u) == 0u) { if (xb_ld(&(bar)[XB_TMO])) break; if (_sp > XB_SPIN_CAP) { atomicAdd(&(bar)[XB_TMO], 1u); break; } } } } while (0)

struct XcdBarrier {
    unsigned* bar; unsigned x;
    volatile LAS unsigned* st;
};

__device__ __forceinline__ XcdBarrier xcd_barrier_post(unsigned* bar, volatile LAS unsigned* st) {
    XcdBarrier b; b.bar = bar; b.x = xb_xcc_id(); b.st = st;
    if (threadIdx.x == 0) (void)xb_add(&bar[XB_XCNT(b.x)], 1u);
    return b;
}
__device__ __forceinline__ void xcd_barrier_complete(unsigned* bar, unsigned x, unsigned& nloc, unsigned& nx) {
    const unsigned G = gridDim.x * gridDim.y * gridDim.z;
    unsigned sum, cnt, mine, sp = 0u;
    for (;;) {
        sum = 0u; cnt = 0u; mine = 0u;
#pragma unroll
        for (unsigned j = 0; j < 16; ++j) { const unsigned c = xb_ld(&bar[XB_XCNT(j)]); sum += c; cnt += (c > 0u) ? 1u : 0u; mine = (j == x) ? c : mine; }
        if (sum == G) break;
        __builtin_amdgcn_s_sleep(1);
        if ((++sp & 255u) == 0u) { if (xb_ld(&bar[XB_TMO])) break; if (sp > XB_SPIN_CAP) { atomicAdd(&bar[XB_TMO], 1u); break; } }
    }
    nloc = mine > 0u ? mine : 1u; nx = cnt > 0u ? cnt : 1u;
}

__device__ __forceinline__ void xcd_barrier(const XcdBarrier& b) {
    asm volatile("s_waitcnt vmcnt(0)" ::: "memory");
    __syncthreads();
    if (threadIdx.x == 0) {
        unsigned* bar = b.bar;
        __builtin_amdgcn_s_waitcnt(0);
        unsigned nloc = b.st[0], nx = b.st[1];
        if (nloc == 0u) { xcd_barrier_complete(bar, b.x, nloc, nx); b.st[0] = nloc; b.st[1] = nx; }
        const unsigned old = xb_add(&bar[XB_XSUB(b.x)], 1u);
        const unsigned gen = old / nloc;
        if (old + 1u == (gen + 1u) * nloc) {
            __builtin_amdgcn_fence(__ATOMIC_RELEASE, "agent");
            asm volatile("s_waitcnt vmcnt(0)" ::: "memory");
            const unsigned og = xb_add(&bar[XB_TOP], 1u);
            const unsigned tg = og / nx;
            if (og + 1u == (tg + 1u) * nx) xb_add(&bar[XB_TOPGEN], 1u);
            else XB_SPIN(xb_ld(&bar[XB_TOPGEN]) == tg, bar);
            __builtin_amdgcn_fence(__ATOMIC_ACQUIRE, "agent");
            xb_add(&bar[XB_XGEN(b.x)], 1u);
            asm volatile("s_waitcnt vmcnt(0)" ::: "memory");
        } else {
            XB_SPIN(xb_ld(&bar[XB_XGEN(b.x)]) == gen, bar);
            __builtin_amdgcn_fence(__ATOMIC_ACQUIRE, "agent");
            asm volatile("s_waitcnt vmcnt(0)" ::: "memory");
        }
    }
    __syncthreads();
}

struct Args {
    const float* in[32]; float* out; unsigned char* ws; int nprog; unsigned char prog[60];
};

struct Ctx { int tid, lane, wave, gw, NGW, bid, G; };
__device__ __forceinline__ Ctx make_ctx() {
    int tid = threadIdx.x; asm volatile("" : "+v"(tid));
    int bid = blockIdx.x; asm volatile("" : "+s"(bid));
    Ctx c; c.tid = tid; c.lane = tid & 63; c.wave = __builtin_amdgcn_readfirstlane(tid >> 6); c.bid = bid; c.G = gridDim.x;
    c.gw = bid * NWAVES + c.wave; c.NGW = c.G * NWAVES; return c;
}

constexpr int SP_LD = 132;
template <class EpiS>
__device__ __forceinline__ void small_gemm(LAS unsigned char* lds, const bf16_t* A, int lda, const bf16_t* Bt, int ldb, int K, int N, const EpiS& E, const Ctx& c) {
    const int lane = c.lane, fr = lane & 15, fq = lane >> 4, w = c.wave;
    const int nct = N / 128, kw = K / 8;
    LAS float* P = (LAS float*)lds;
    for (int u = c.bid; u < 32 * nct; u += c.G) {
        const int ct = u % nct, rt = u / nct, r0 = 32 * rt, n0 = 128 * ct;
        f32x4 acc[2][8];
#pragma unroll
        for (int mt = 0; mt < 2; ++mt)
#pragma unroll
            for (int nt = 0; nt < 8; ++nt) acc[mt][nt] = (f32x4){0.f, 0.f, 0.f, 0.f};
        const bf16_t* ap = A + (size_t)(r0 + fr) * lda + w * kw + 8 * fq;
        const bf16_t* bp = Bt + (size_t)(n0 + fr) * ldb + w * kw + 8 * fq;
        bf16x8 a0[2], b0[8], a1[2], b1[8];
#define SG_LOAD(AF, BF, K0) do { _Pragma("unroll") for (int mt = 0; mt < 2; ++mt) AF[mt] = *(const bf16x8*)(ap + (size_t)16 * mt * lda + (K0)); \
        _Pragma("unroll") for (int nt = 0; nt < 8; ++nt) BF[nt] = *(const bf16x8*)(bp + (size_t)16 * nt * ldb + (K0)); } while (0)
#define SG_MMA(AF, BF) do { _Pragma("unroll") for (int mt = 0; mt < 2; ++mt) _Pragma("unroll") for (int nt = 0; nt < 8; ++nt) \
        acc[mt][nt] = __builtin_amdgcn_mfma_f32_16x16x32_bf16(BF[nt], AF[mt], acc[mt][nt], 0, 0, 0); } while (0)
        SG_LOAD(a0, b0, 0);
        for (int k0 = 0; k0 < kw; k0 += 64) {
            SG_LOAD(a1, b1, k0 + 32);
            SG_MMA(a0, b0);
            if (k0 + 64 < kw) SG_LOAD(a0, b0, k0 + 64);
            SG_MMA(a1, b1);
        }
#undef SG_LOAD
#undef SG_MMA
        LAS float* pw = P + w * 32 * SP_LD;
#pragma unroll
        for (int mt = 0; mt < 2; ++mt)
#pragma unroll
            for (int nt = 0; nt < 8; ++nt) *(LAS f32x4*)(pw + (16 * mt + fr) * SP_LD + 16 * nt + 4 * fq) = acc[mt][nt];
        __syncthreads();
        const int row = c.tid >> 4, c8 = (c.tid & 15) * 8;
        f32x4 v0 = (f32x4){0.f, 0.f, 0.f, 0.f}, v1 = v0;
#pragma unroll
        for (int ww = 0; ww < 8; ++ww) { v0 += *(const LAS f32x4*)(P + (ww * 32 + row) * SP_LD + c8); v1 += *(const LAS f32x4*)(P + (ww * 32 + row) * SP_LD + c8 + 4); }
        E(r0 + row, n0 + c8, v0, v1);
        __syncthreads();
    }
}
struct EpiSRes {
    float* X; const float* gate; const float* base;
    __device__ __forceinline__ void operator()(int row, int col, f32x4 v0, f32x4 v1) const {
        const float* gp = gate + (size_t)(2 + (row >> 3)) * MODLD + col;
        float* xp = X + (size_t)(MP + row) * 1024 + col;
        const float* bp = base + (size_t)row * 1024 + col;
        const f32x4 g0 = *(const f32x4*)gp, g1 = *(const f32x4*)(gp + 4);
        f32x4 x0 = *(const f32x4*)bp, x1 = *(const f32x4*)(bp + 4);
        x0 += g0 * v0; x1 += g1 * v1;
        *(f32x4*)xp = x0; *(f32x4*)(xp + 4) = x1;
    }
};
struct EpiSUp {
    bf16_t* O;
    __device__ __forceinline__ void operator()(int row, int col, f32x4 v0, f32x4 v1) const {
#pragma unroll
        for (int i = 0; i < 4; ++i) { const float a = fmaxf(v0[i], 0.f), b = fmaxf(v1[i], 0.f); v0[i] = a * a; v1[i] = b * b; }
        store8(O + (size_t)(MP + row) * FF + col, v0, v1);
    }
};
struct EpiSBranch {
    bf16_t* MG; const unsigned char* Gt; int first;
    __device__ __forceinline__ void operator()(int row, int col, f32x4 v0, f32x4 v1) const {
        const size_t r = (size_t)(MP + row);
        const u32x2 gw = *(const u32x2*)(Gt + r * 4096 + col);
        v0[0] *= ub(gw.x, 0); v0[1] *= ub(gw.x, 1); v0[2] *= ub(gw.x, 2); v0[3] *= ub(gw.x, 3);
        v1[0] *= ub(gw.y, 0); v1[1] *= ub(gw.y, 1); v1[2] *= ub(gw.y, 2); v1[3] *= ub(gw.y, 3);
        bf16_t* mp = MG + r * 1024 + col;
        if (!first) {
            const u32x4 mw = *(const u32x4*)mp;
            v0[0] += bflo(mw.x); v0[1] += bfhi(mw.x); v0[2] += bflo(mw.y); v0[3] += bfhi(mw.y);
            v1[0] += bflo(mw.z); v1[1] += bfhi(mw.z); v1[2] += bflo(mw.w); v1[3] += bfhi(mw.w);
        }
        store8(mp, v0, v1);
    }
};

__device__ __forceinline__ int perm_in(int s) {
    if (s >= 1536 && s < 2560) { const int o = s - 1536, bj = o >> 9, r = o & 511; return 1536 + ((r >> 7) << 8) + (bj << 7) + (r & 127); }
    if (s >= 3072 && s < 4096) { const int o = s - 3072, bj = o >> 9, r = o & 511; return 3072 + ((r >> 7) << 8) + (bj << 7) + (r & 127); }
    return s;
}
constexpr int TT_LD = 257;
__device__ __forceinline__ int transpose_tiles(const float* W, int K, int N, bf16_t* WT, int row_off, int mode, LAS float* tl, int base, int bid, int G, int tid) {
    const int ntn = N / 256, ntiles = (K / 64) * ntn, lane = tid & 63, wid = tid >> 6;
    int t = bid - base % G; if (t < 0) t += G;
    for (; t < ntiles; t += G) {
        const int kb = t / ntn, nb = t % ntn, k0 = 64 * kb, n0 = 256 * nb;
        float v[8][4];
#pragma unroll
        for (int i = 0; i < 8; ++i)
#pragma unroll
            for (int cc = 0; cc < 4; ++cc) v[i][cc] = __builtin_nontemporal_load(&W[(size_t)(k0 + 8 * wid + i) * N + n0 + 64 * cc + lane]);
#pragma unroll
        for (int i = 0; i < 8; ++i)
#pragma unroll
            for (int cc = 0; cc < 4; ++cc) tl[(8 * wid + i) * TT_LD + 64 * cc + lane] = v[i][cc];
        __syncthreads();
        const int ch = tid & 7;
#pragma unroll
        for (int qq = 0; qq < 4; ++qq) {
            const int n = (tid >> 3) + 64 * qq;
            const LAS float* sp = tl + (8 * ch) * TT_LD + n;
            u32x4 o; o.x = cvtpk(sp[0 * TT_LD], sp[1 * TT_LD]); o.y = cvtpk(sp[2 * TT_LD], sp[3 * TT_LD]); o.z = cvtpk(sp[4 * TT_LD], sp[5 * TT_LD]); o.w = cvtpk(sp[6 * TT_LD], sp[7 * TT_LD]);
            const int dn = row_off + (mode == 1 ? perm_in(n0 + n) : n0 + n);
            *(u32x4*)(WT + (size_t)dn * K + k0 + 8 * ch) = o;
        }
        __syncthreads();
    }
    return base + ntiles;
}

__device__ __forceinline__ void adaln_rows(const float* xp, const float* xs, float* Xcopy, bf16_t* Hout, const float* g, const float* shift, const float* scale, const Ctx& c) {
    constexpr int RPI = 5;
    f32x4 gg[4];
#pragma unroll
    for (int j = 0; j < 4; ++j) gg[j] = *(const f32x4*)(g + 4 * (c.lane + 64 * j));
    for (int row0 = RPI * c.gw; row0 < M; row0 += RPI * c.NGW) {
        f32x4 v[RPI][4]; float ss[RPI];
#pragma unroll
        for (int rr = 0; rr < RPI; ++rr) {
            const int row = min(row0 + rr, M - 1);
            const float* src = row < MP ? xp + (size_t)row * D : xs + (size_t)(row - MP) * D;
#pragma unroll
            for (int j = 0; j < 4; ++j) v[rr][j] = *(const f32x4*)(src + 4 * (c.lane + 64 * j));
        }
        const int bA = bidx(row0), bB = bidx(min(row0 + RPI - 1, M - 1));
        const bool same_b = bA == bB;
        f32x4 ps1[4], ps0[4];
        if (same_b) {
#pragma unroll
            for (int j = 0; j < 4; ++j) { ps1[j] = *(const f32x4*)(scale + (size_t)bA * MODLD + 4 * (c.lane + 64 * j)); ps0[j] = *(const f32x4*)(shift + (size_t)bA * MODLD + 4 * (c.lane + 64 * j)); }
        } else {
#pragma unroll
            for (int j = 0; j < 4; ++j) { ps1[j] = (f32x4){0.f, 0.f, 0.f, 0.f}; ps0[j] = ps1[j]; }
        }
#pragma unroll
        for (int rr = 0; rr < RPI; ++rr) {
            float a = 0.f;
#pragma unroll
            for (int j = 0; j < 4; ++j) a += (v[rr][j][0] * v[rr][j][0] + v[rr][j][1] * v[rr][j][1]) + (v[rr][j][2] * v[rr][j][2] + v[rr][j][3] * v[rr][j][3]);
            ss[rr] = a;
        }
#pragma unroll
        for (int o = 1; o < 64; o <<= 1)
#pragma unroll
            for (int rr = 0; rr < RPI; ++rr) ss[rr] += __shfl_xor(ss[rr], o);
#pragma unroll
        for (int rr = 0; rr < RPI; ++rr) {
            const int row = row0 + rr;
            if (row < M) {
                const int b = bidx(row);
                const float* sh = shift + (size_t)b * MODLD; const float* sc = scale + (size_t)b * MODLD;
                const float rstd = 1.0f / sqrtf(ss[rr] * (1.f / D) + EPS);
#pragma unroll
                for (int j = 0; j < 4; ++j) {
                    const int col = 4 * (c.lane + 64 * j);
                    if (Xcopy) *(f32x4*)(Xcopy + (size_t)row * D + col) = v[rr][j];
                    const f32x4 s1 = same_b ? ps1[j] : *(const f32x4*)(sc + col), s0 = same_b ? ps0[j] : *(const f32x4*)(sh + col);
                    const f32x4 o = v[rr][j] * rstd * gg[j] * (s1 + 1.0f) + s0;
                    u32x2 w; w.x = cvtpk(o[0], o[1]); w.y = cvtpk(o[2], o[3]);
                    *(u32x2*)(Hout + (size_t)row * D + col) = w;
                }
            }
        }
    }
}

struct C0P {
    bf16_t *Q, *KV, *VV; const bf16_t *GLU, *CGH;
    const float *qg, *kg, *lncg, *lncb, *cache_k, *cache_v, *state_a; float* out; int l;
};
__device__ __forceinline__ void phase_c0(const C0P& p, const Ctx& c) {
    const int lane = c.lane, hl = lane >> 4, e = lane & 15;
    const double invf[8] = {1.0, 0.19392274474868576, 0.03760603093086393, 0.007292664737217109, 0.001414213562373095, 0.0002742481756762073, 5.318295896944988e-05, 1.031338537721246e-05};
    const f32x4 kgg = *(const f32x4*)(p.kg + 4 * e);
    const f32x4 lg0 = *(const f32x4*)(p.lncg + 8 * lane), lg1 = *(const f32x4*)(p.lncg + 8 * lane + 4), lb0 = *(const f32x4*)(p.lncb + 8 * lane), lb1 = *(const f32x4*)(p.lncb + 8 * lane + 4);
    auto do_row = [&](int row, u32x2 wk, u32x2 wvr, u32x4 wvv) {
        const int pos = row < MP ? (row & (SEQ - 1)) : MP + ((row - MP) & 7);
        float cs[4], sn[4];
#pragma unroll
        for (int i = 0; i < 4; ++i) {
            const int fi = 4 * (e & 1) + i;
            double iv = invf[0];
#pragma unroll
            for (int k = 1; k < 8; ++k) iv = (fi == k) ? invf[k] : iv;
            const double rev = (double)pos * iv * 0.15915494309189535;
            const float fr = (float)(rev - __builtin_rint(rev));
            cs[i] = __builtin_amdgcn_cosf(fr); sn[i] = __builtin_amdgcn_sinf(fr);
        }
        long kvo = -1;
        if (row < MP) { const int t = row & (SEQ - 1); if (t >= SEQ - 128) kvo = ((long)(p.l * 2 + (row >> 13)) * 128 + (t - (SEQ - 128))) * 256; }
        else { const int bs = (row - MP) >> 3, t = (row - MP) & 7; kvo = ((long)(p.l * DECB + bs) * 128 + 120 + t) * 256; }
        const size_t ok_base = row < MP ? O_PK : O_SK, ov_base = row < MP ? O_PV : O_SV;
        {
            f32x4 x = {bflo(wk.x), bfhi(wk.x), bflo(wk.y), bfhi(wk.y)};
            float ss = (x[0] * x[0] + x[1] * x[1]) + (x[2] * x[2] + x[3] * x[3]);
            ss += __shfl_xor(ss, 1); ss += __shfl_xor(ss, 2); ss += __shfl_xor(ss, 4); ss += __shfl_xor(ss, 8);
            const float rstd = 1.0f / sqrtf(ss * (1.f / 64.f) + EPS);
            x = x * rstd * kgg;
            f32x4 pr;
#pragma unroll
            for (int i = 0; i < 4; ++i) pr[i] = __shfl_xor(x[i], 2);
            if (e < 4) {
#pragma unroll
                for (int i = 0; i < 4; ++i) x[i] = (e < 2) ? (x[i] * cs[i] - pr[i] * sn[i]) : (x[i] * cs[i] + pr[i] * sn[i]);
            }
            u32x2 o; o.x = cvtpk(x[0], x[1]); o.y = cvtpk(x[2], x[3]);
            *(u32x2*)(p.KV + (size_t)row * 512 + hl * 64 + 4 * e) = o;
            if (kvo >= 0) *(f32x4*)(p.out + ok_base + kvo + hl * 64 + 4 * e) = x;
        }
        if (kvo >= 0) *(f32x4*)(p.out + ov_base + kvo + hl * 64 + 4 * e) = (f32x4){bflo(wvr.x), bfhi(wvr.x), bflo(wvr.y), bfhi(wvr.y)};
        {
            bf16_t* vp = p.VV + (size_t)row * 512 + 8 * lane;
            const u32x4 w = wvv;
            float v[8] = {bflo(w.x), bfhi(w.x), bflo(w.y), bfhi(w.y), bflo(w.z), bfhi(w.z), bflo(w.w), bfhi(w.w)};
            float s = 0.f;
#pragma unroll
            for (int i = 0; i < 8; ++i) s += v[i];
            const float mean = wave_sum(s) * (1.f / 512.f);
            float q = 0.f;
#pragma unroll
            for (int i = 0; i < 8; ++i) { v[i] -= mean; q += v[i] * v[i]; }
            const float rstd = 1.0f / sqrtf(wave_sum(q) * (1.f / 512.f) + EPS);
            f32x4 o0, o1;
#pragma unroll
            for (int i = 0; i < 4; ++i) { o0[i] = v[i] * rstd * lg0[i] + lb0[i]; o1[i] = v[4 + i] * rstd * lg1[i] + lb1[i]; }
            store8(vp, o0, o1);
            if (row >= MP) { float* og = p.out + O_SG + ((size_t)p.l * MS + (row - MP)) * 512 + 8 * lane; *(f32x4*)og = o0; *(f32x4*)(og + 4) = o1; }
        }
    };
    constexpr int RP = 4;
    for (int row0 = RP * c.gw; row0 < M; row0 += RP * c.NGW) {
        u32x2 wk[RP], wv[RP]; u32x4 wvv[RP];
#pragma unroll
        for (int rr = 0; rr < RP; ++rr) {
            const size_t row = (size_t)(row0 + rr);
            wk[rr] = *(const u32x2*)(p.KV + row * 512 + hl * 64 + 4 * e); wv[rr] = *(const u32x2*)(p.KV + row * 512 + 256 + hl * 64 + 4 * e);
            wvv[rr] = *(const u32x4*)(p.VV + row * 512 + 8 * lane);
        }
#pragma unroll
        for (int rr = 0; rr < RP; ++rr) do_row(row0 + rr, wk[rr], wv[rr], wvv[rr]);
    }
    const long gt = (long)c.gw * 64 + c.lane, NT = (long)c.NGW * 64;
    for (long i = gt; i < 2 * 30 * 128; i += NT) {
        const int b = (int)(i / (30 * 128)), r = (int)(i % (30 * 128)), j = r >> 7, c4 = (r & 127) * 4;
        const u32x2 w = *(const u32x2*)(p.GLU + ((size_t)b * SEQ + SEQ - 30 + j) * 512 + c4);
        *(f32x4*)(p.out + O_PA + (((size_t)p.l * 2 + b) * 30 + j) * 512 + c4) = (f32x4){bflo(w.x), bfhi(w.x), bflo(w.y), bfhi(w.y)};
    }
    for (long i0 = gt; i0 < (long)DECB * 30 * 128; i0 += 4 * NT) {
        f32x4 v[4]; size_t dsts[4]; bool ok[4];
#pragma unroll
        for (int u4 = 0; u4 < 4; ++u4) {
            const long i = i0 + u4 * NT; ok[u4] = i < (long)DECB * 30 * 128;
            const long ii = ok[u4] ? i : 0;
            const int b = (int)(ii / (30 * 128)), r = (int)(ii % (30 * 128)), j = r >> 7, c4 = (r & 127) * 4;
            if (j < 22) v[u4] = *(const f32x4*)(p.state_a + (((size_t)p.l * DECB + b) * 30 + j + 8) * 512 + c4);
            else { const u32x2 w = *(const u32x2*)(p.GLU + ((size_t)MP + b * 8 + (j - 22)) * 512 + c4); v[u4] = (f32x4){bflo(w.x), bfhi(w.x), bflo(w.y), bfhi(w.y)}; }
            dsts[u4] = (((size_t)p.l * DECB + b) * 30 + j) * 512 + c4;
        }
#pragma unroll
        for (int u4 = 0; u4 < 4; ++u4) if (ok[u4]) *(f32x4*)(p.out + O_SA + dsts[u4]) = v[u4];
    }
    for (long i = gt; i < 2 * 2 * 128; i += NT) {
        const int b = (int)(i / 256), r = (int)(i % 256), j = r >> 7, c4 = (r & 127) * 4;
        const u32x2 w = *(const u32x2*)(p.CGH + ((size_t)b * SEQ + SEQ - 2 + j) * 512 + c4);
        *(f32x4*)(p.out + O_PB + (((size_t)p.l * 2 + b) * 2 + j) * 512 + c4) = (f32x4){bflo(w.x), bfhi(w.x), bflo(w.y), bfhi(w.y)};
    }
    for (long i = gt; i < (long)DECB * 2 * 128; i += NT) {
        const int b = (int)(i / 256), r = (int)(i % 256), j = r >> 7, c4 = (r & 127) * 4;
        const u32x2 w = *(const u32x2*)(p.CGH + ((size_t)MP + b * 8 + 6 + j) * 512 + c4);
        *(f32x4*)(p.out + O_SB + (((size_t)p.l * DECB + b) * 2 + j) * 512 + c4) = (f32x4){bflo(w.x), bfhi(w.x), bflo(w.y), bfhi(w.y)};
    }
}

constexpr int KS_LD = 72, VT_LD = 264;
constexpr int KS_BYTES = 256 * KS_LD * 2, VT_BYTES = 64 * VT_LD * 2;

template <bool SAMPLE>
__device__ __forceinline__ void attn_wave(const LAS bf16_t* Ks, const LAS bf16_t* Vt, int kbase, int kmin, bf16_t* Qb  ,
                                          const float* sinks  , const float* qg, int pos_base, int lane) {
    const int q = lane & 31, hi = lane >> 5;
    auto rowoff = [&](int r) -> size_t { return SAMPLE ? (size_t)(r & 7) * 1024 + (r >> 3) * 64 : (size_t)r * 1024; };
    const bf16_t* Qp = Qb + rowoff(q);
    const int lo = SAMPLE ? (q & 7) : q;
    const float sink = (SAMPLE ? sinks[q >> 3] : sinks[0]) * 1.4426950408889634f;
    bf16x8 qf[4];
#pragma unroll
    for (int d0 = 0; d0 < 4; ++d0) qf[d0] = *(const bf16x8*)(Qp + 16 * d0 + 8 * hi);
    {
        float x[4][8]; float ssq = 0.f;
#pragma unroll
        for (int d0 = 0; d0 < 4; ++d0)
#pragma unroll
            for (int j = 0; j < 8; ++j) { x[d0][j] = bf2f((bf16_t)qf[d0][j]); ssq += x[d0][j] * x[d0][j]; }
        f32x4 qg0[4], qg1[4];
#pragma unroll
        for (int d0 = 0; d0 < 4; ++d0) { qg0[d0] = *(const f32x4*)(qg + 16 * d0 + 8 * hi); qg1[d0] = *(const f32x4*)(qg + 16 * d0 + 8 * hi + 4); }
        ssq += __shfl_xor(ssq, 32);
        const float rstd = 1.0f / sqrtf(ssq * (1.f / 64.f) + EPS);
#pragma unroll
        for (int d0 = 0; d0 < 4; ++d0) {
#pragma unroll
            for (int j = 0; j < 4; ++j) { x[d0][j] *= rstd * qg0[d0][j]; x[d0][4 + j] *= rstd * qg1[d0][j]; }
        }
        const int pos = pos_base + (SAMPLE ? (q & 7) : q);
        const double invf[8] = {1.0, 0.19392274474868576, 0.03760603093086393, 0.007292664737217109, 0.001414213562373095, 0.0002742481756762073, 5.318295896944988e-05, 1.031338537721246e-05};
#pragma unroll
        for (int j = 0; j < 8; ++j) {
            const double rev = (double)pos * invf[j] * 0.15915494309189535;
            const float fr = (float)(rev - __builtin_rint(rev));
            const float cs = __builtin_amdgcn_cosf(fr), sn = __builtin_amdgcn_sinf(fr);
            const float pr = __shfl_xor(x[0][j], 32);
            x[0][j] = hi == 0 ? (x[0][j] * cs - pr * sn) : (x[0][j] * cs + pr * sn);
        }
#pragma unroll
        for (int d0 = 0; d0 < 4; ++d0) {
            u32x4 w; w.x = cvtpk(x[d0][0], x[d0][1]); w.y = cvtpk(x[d0][2], x[d0][3]); w.z = cvtpk(x[d0][4], x[d0][5]); w.w = cvtpk(x[d0][6], x[d0][7]);
            qf[d0] = __builtin_bit_cast(bf16x8, w);
        }
    }
    f32x16 s[5];
#pragma unroll
    for (int t = 0; t < 5; ++t) {
        s[t] = (f32x16){0.f, 0.f, 0.f, 0.f, 0.f, 0.f, 0.f, 0.f, 0.f, 0.f, 0.f, 0.f, 0.f, 0.f, 0.f, 0.f};
        const LAS bf16_t* kp = Ks + (kbase + 32 * t + q) * KS_LD + 8 * hi;
#pragma unroll
        for (int d0 = 0; d0 < 4; ++d0) { const bf16x8 kf = *(const LAS bf16x8*)(kp + 16 * d0); s[t] = __builtin_amdgcn_mfma_f32_32x32x16_bf16(kf, qf[d0], s[t], 0, 0, 0); }
        asm volatile("" ::: "memory");
    }
    const float sc = 0.125f * 1.4426950408889634f;
#pragma unroll
    for (int r = 0; r < 16; ++r) {
        const int k0 = crow(r, hi);
        s[0][r] = (k0 >= lo) ? s[0][r] : -1e30f;
        s[4][r] = (k0 <= lo) ? s[4][r] : -1e30f;
    }
    if (kmin > 0) {
#pragma unroll
        for (int t = 0; t < 5; ++t)
#pragma unroll
            for (int r = 0; r < 16; ++r) s[t][r] = (kbase + 32 * t + crow(r, hi) >= kmin) ? s[t][r] : -1e30f;
    }
    float mraw = -1e30f;
#pragma unroll
    for (int t = 0; t < 5; ++t)
#pragma unroll
        for (int r = 0; r < 16; ++r) mraw = fmaxf(mraw, s[t][r]);
    float mx = fmaxf(mraw * sc, sink);
    mx = fmaxf(mx, __shfl_xor(mx, 32));
    float sum = 0.f;
    f32x16 o[2];
    o[0] = (f32x16){0.f, 0.f, 0.f, 0.f, 0.f, 0.f, 0.f, 0.f, 0.f, 0.f, 0.f, 0.f, 0.f, 0.f, 0.f, 0.f}; o[1] = o[0];
#pragma unroll
    for (int t = 0; t < 5; ++t) {
#pragma unroll
        for (int cc = 0; cc < 2; ++cc) {
            float pv[8];
#pragma unroll
            for (int j = 0; j < 8; ++j) { pv[j] = __builtin_amdgcn_exp2f(fmaxf(s[t][8 * cc + j] * sc - mx, -126.f)); sum += pv[j]; }
            u32x4 pw; pw.x = cvtpk(pv[0], pv[1]); pw.y = cvtpk(pv[2], pv[3]); pw.z = cvtpk(pv[4], pv[5]); pw.w = cvtpk(pv[6], pv[7]);
            const bf16x8 pa = __builtin_bit_cast(bf16x8, pw);
#pragma unroll
            for (int dt = 0; dt < 2; ++dt) {
                const LAS bf16_t* vp = Vt + (32 * dt + q) * VT_LD + kbase + 32 * t + 16 * cc + 4 * hi;
                const s16x4 v0 = *(const LAS s16x4*)vp, v1 = *(const LAS s16x4*)(vp + 8);
                const bf16x8 vb = (bf16x8){v0[0], v0[1], v0[2], v0[3], v1[0], v1[1], v1[2], v1[3]};
                o[dt] = __builtin_amdgcn_mfma_f32_32x32x16_bf16(pa, vb, o[dt], 0, 0, 0);
            }
        }
        asm volatile("" ::: "memory");
    }
    sum += __shfl_xor(sum, 32);
    sum += __builtin_amdgcn_exp2f(sink - mx);
    const float inv = 1.0f / sum;
#pragma unroll
    for (int r = 0; r < 16; ++r) {
        const int qr = crow(r, hi);
        const float iv = __shfl(inv, qr);
        bf16_t* op = Qb + rowoff(qr) + q;
        op[0] = f2bf(o[0][r] * iv); op[32] = f2bf(o[1][r] * iv);
    }
}

struct C1P {
    bf16_t *Q, *BG, *U, *AACT; const bf16_t *KV, *GLU, *CGH, *VV, *WSP;
    const float *sinks, *cache_k, *cache_v, *state_a, *state_b, *conv_a_w, *conv_a_b, *ln_a_g, *ln_a_b, *conv_b_w, *w_sp, *b_sp; int l; const float* qg; float* out;
};

__device__ __forceinline__ void transpose8x8(const u32x4 (&r)[8], u32x4 (&o)[8]) {
#pragma unroll
    for (int j = 0; j < 8; ++j)
#pragma unroll
        for (int k = 0; k < 4; ++k) {
            const unsigned a = r[2 * k][j >> 1], b = r[2 * k + 1][j >> 1];
            o[j][k] = (j & 1) ? ((a >> 16) | (b & 0xffff0000u)) : ((a & 0xffffu) | (b << 16));
        }
}
__device__ __forceinline__ void vt_scatter(LAS bf16_t* Vt, int ld, int d0, int row, u32x4 vv) {
    Vt[(d0 + 0) * ld + row] = (bf16_t)(vv.x & 0xffffu); Vt[(d0 + 1) * ld + row] = (bf16_t)(vv.x >> 16);
    Vt[(d0 + 2) * ld + row] = (bf16_t)(vv.y & 0xffffu); Vt[(d0 + 3) * ld + row] = (bf16_t)(vv.y >> 16);
    Vt[(d0 + 4) * ld + row] = (bf16_t)(vv.z & 0xffffu); Vt[(d0 + 5) * ld + row] = (bf16_t)(vv.z >> 16);
    Vt[(d0 + 6) * ld + row] = (bf16_t)(vv.w & 0xffffu); Vt[(d0 + 7) * ld + row] = (bf16_t)(vv.w >> 16);
}

__device__ __forceinline__ void phase_attn(const C1P& p, LAS unsigned char* lds, const Ctx& c) {
    const int tid = c.tid, wid = c.wave, lane = c.lane;
    LAS bf16_t* Ks = (LAS bf16_t*)lds; LAS bf16_t* Vt = (LAS bf16_t*)(lds + KS_BYTES);
    for (int u = c.bid; u < 2 * 4 * 64; u += c.G) {
        const int i = u & 63, kvh = (u >> 6) & 3, b = u >> 8;
        {
            u32x4 kk[4], vr[8], vo[8];
#pragma unroll
            for (int it = 0; it < 4; ++it) {
                const int id = tid + 512 * it, row = id >> 3, ch = id & 7, pos = (i - 1) * 128 + row;
                kk[it] = (u32x4){0u, 0u, 0u, 0u};
                if (pos >= 0) kk[it] = *(const u32x4*)(p.KV + ((size_t)b * SEQ + pos) * 512 + kvh * 64 + ch * 8);
            }
            const int sb = tid & 31, db = tid >> 5;
            if (tid < 256) {
#pragma unroll
                for (int r8 = 0; r8 < 8; ++r8) {
                    const int pos = (i - 1) * 128 + 8 * sb + r8;
                    vr[r8] = (u32x4){0u, 0u, 0u, 0u};
                    if (pos >= 0) vr[r8] = *(const u32x4*)(p.KV + ((size_t)b * SEQ + pos) * 512 + 256 + kvh * 64 + db * 8);
                }
            }
#pragma unroll
            for (int it = 0; it < 4; ++it) { const int id = tid + 512 * it, row = id >> 3, ch = id & 7; *(LAS u32x4*)(Ks + row * KS_LD + ch * 8) = kk[it]; }
            if (tid < 256) {
                transpose8x8(vr, vo);
#pragma unroll
                for (int j = 0; j < 8; ++j) *(LAS u32x4*)(Vt + (8 * db + j) * VT_LD + 8 * sb) = vo[j];
            }
        }
        __syncthreads();
        const int head = kvh * 4 + (wid >> 1);
#pragma unroll 1
        for (int a2 = 0; a2 < 2; ++a2) {
            const int a = 2 * (wid & 1) + a2;
            attn_wave<false>(Ks, Vt, 32 * a, (i == 0) ? 128 : 0, p.Q + ((size_t)b * SEQ + i * 128 + 32 * a) * 1024 + head * 64, p.sinks + head, p.qg, i * 128 + 32 * a, lane);
        }
        __syncthreads();
    }
    constexpr int REG = KS_BYTES + VT_BYTES;
    for (int u = c.bid; u < DECB * 2; u += c.G) {
        const int b = u >> 1, kp = u & 1;
#pragma unroll
        for (int it = 0; it < 5; ++it) {
            const int id = tid + 512 * it;
            const int sel = id / 1280, rem = id % 1280, row = rem >> 3, ch = rem & 7, kvh = 2 * kp + sel;
            LAS bf16_t* Ks2 = (LAS bf16_t*)(lds + sel * REG);
            u32x4 kk = {0u, 0u, 0u, 0u};
            if (row < 128) {
                const size_t so = (((size_t)(p.l * DECB + b) * 128 + row) * 4 + kvh) * 64 + ch * 8;
                const f32x4 k0 = __builtin_nontemporal_load((const f32x4*)(p.cache_k + so)), k1 = __builtin_nontemporal_load((const f32x4*)(p.cache_k + so + 4));
                kk.x = cvtpk(k0[0], k0[1]); kk.y = cvtpk(k0[2], k0[3]); kk.z = cvtpk(k1[0], k1[1]); kk.w = cvtpk(k1[2], k1[3]);
                if (row >= 8) {
                    float* o = p.out + O_SK + (((size_t)(p.l * DECB + b) * 128 + (row - 8)) * 4 + kvh) * 64 + ch * 8; *(f32x4*)o = k0; *(f32x4*)(o + 4) = k1; }
            } else if (row < 136) {
                kk = *(const u32x4*)(p.KV + ((size_t)MP + b * 8 + (row - 128)) * 512 + kvh * 64 + ch * 8);
            }
            *(LAS u32x4*)(Ks2 + row * KS_LD + ch * 8) = kk;
        }
        if (tid < 320) {
            const int sel = tid / 160, rem = tid % 160, sb = rem % 20, db = rem / 20, kvh = 2 * kp + sel;
            LAS bf16_t* Vt2 = (LAS bf16_t*)(lds + sel * REG + KS_BYTES);
            u32x4 vr[8], vo[8];
            if (sb < 16) {
#pragma unroll
                for (int r8 = 0; r8 < 8; ++r8) {
                    const size_t so = (((size_t)(p.l * DECB + b) * 128 + 8 * sb + r8) * 4 + kvh) * 64 + db * 8;
                    const f32x4 v0 = __builtin_nontemporal_load((const f32x4*)(p.cache_v + so)), v1 = __builtin_nontemporal_load((const f32x4*)(p.cache_v + so + 4));
                    vr[r8].x = cvtpk(v0[0], v0[1]); vr[r8].y = cvtpk(v0[2], v0[3]); vr[r8].z = cvtpk(v1[0], v1[1]); vr[r8].w = cvtpk(v1[2], v1[3]);
                    if (sb >= 1) { float* o = p.out + O_SV + (((size_t)(p.l * DECB + b) * 128 + (8 * sb + r8 - 8)) * 4 + kvh) * 64 + db * 8; *(f32x4*)o = v0; *(f32x4*)(o + 4) = v1; }
                }
            } else if (sb == 16) {
#pragma unroll
                for (int r8 = 0; r8 < 8; ++r8) vr[r8] = *(const u32x4*)(p.KV + ((size_t)MP + b * 8 + r8) * 512 + 256 + kvh * 64 + db * 8);
            } else {
#pragma unroll
                for (int r8 = 0; r8 < 8; ++r8) vr[r8] = (u32x4){0u, 0u, 0u, 0u};
            }
            transpose8x8(vr, vo);
#pragma unroll
            for (int j = 0; j < 8; ++j) *(LAS u32x4*)(Vt2 + (8 * db + j) * VT_LD + 8 * sb) = vo[j];
        }
        __syncthreads();
        if (wid < 2) {
            const int kvh = 2 * kp + wid;
            attn_wave<true>((const LAS bf16_t*)(lds + wid * REG), (const LAS bf16_t*)(lds + wid * REG + KS_BYTES), 0, 0, p.Q + ((size_t)MP + b * 8) * 1024 + kvh * 256, p.sinks + kvh * 4, p.qg, MP, lane);
        }
        __syncthreads();
    }
}

template <int NOUT>
__device__ __forceinline__ void conv31(const f32x2v (&x)[NOUT + 30], const f32x2v (&w)[31], f32x2v bias, LAS float* dst  ) {
#pragma unroll
    for (int k = 0; k < NOUT; ++k) {
        f32x2v a = bias;
#pragma unroll
        for (int j = 0; j < 31; ++j) a += w[j] * x[k + j];
        *(LAS f32x2v*)(dst + k * 512) = a;
    }
}
__device__ __forceinline__ void phase_conva(const C1P& p, LAS unsigned char* lds, const Ctx& c) {
    const int tid = c.tid, wid = c.wave, lane = c.lane, c2 = tid & 255, h = tid >> 8;
    LAS float* buf = (LAS float*)lds;
    f32x2v w[31];
#pragma unroll
    for (int j = 0; j < 31; ++j) w[j] = *(const f32x2v*)(p.conv_a_w + ((size_t)p.l * 31 + j) * 512 + 2 * c2);
    const f32x2v bias = *(const f32x2v*)(p.conv_a_b + (size_t)p.l * 512 + 2 * c2);
    const f32x4 g0 = *(const f32x4*)(p.ln_a_g + (size_t)p.l * 512 + 8 * lane), g1 = *(const f32x4*)(p.ln_a_g + (size_t)p.l * 512 + 8 * lane + 4);
    const f32x4 b0 = *(const f32x4*)(p.ln_a_b + (size_t)p.l * 512 + 8 * lane), b1 = *(const f32x4*)(p.ln_a_b + (size_t)p.l * 512 + 8 * lane + 4);
    for (int ut = c.bid; ut < M / 64; ut += c.G) {
        const int R0 = 64 * ut;
        if (R0 < MP) {
#pragma unroll 1
            for (int ps = 0; ps < 2; ++ps) {
                const int tb = R0 + 32 * h + 16 * ps, ts = tb & (SEQ - 1);
                f32x2v x[46];
#pragma unroll
                for (int i = 0; i < 46; ++i) {
                    unsigned wv = 0u;
                    if (ts - 30 + i >= 0) wv = *(const unsigned*)(p.GLU + (size_t)(tb - 30 + i) * 512 + 2 * c2);
                    x[i] = (f32x2v){bflo(wv), bfhi(wv)};
                }
                conv31<16>(x, w, bias, buf + (32 * h + 16 * ps) * 512 + 2 * c2);
            }
        } else {
#pragma unroll 1
            for (int sq = 0; sq < 4; ++sq) {
                const int bs = (R0 - MP) / 8 + 4 * h + sq;
                f32x2v x[38];
#pragma unroll
                for (int i = 0; i < 30; ++i) x[i] = *(const f32x2v*)(p.state_a + (((size_t)p.l * DECB + bs) * 30 + i) * 512 + 2 * c2);
#pragma unroll
                for (int i = 0; i < 8; ++i) { const unsigned wv = *(const unsigned*)(p.GLU + ((size_t)MP + bs * 8 + i) * 512 + 2 * c2); x[30 + i] = (f32x2v){bflo(wv), bfhi(wv)}; }
                conv31<8>(x, w, bias, buf + (8 * (4 * h + sq)) * 512 + 2 * c2);
            }
        }
        __syncthreads();
#pragma unroll 4
        for (int k = 0; k < 8; ++k) {
            const int tok = 8 * wid + k;
            f32x4 v0 = *(const LAS f32x4*)(buf + tok * 512 + 8 * lane), v1 = *(const LAS f32x4*)(buf + tok * 512 + 8 * lane + 4);
            const float mean = wave_sum((v0[0] + v0[1]) + (v0[2] + v0[3]) + (v1[0] + v1[1]) + (v1[2] + v1[3])) * (1.f / 512.f);
            v0 -= mean; v1 -= mean;
            const float var = wave_sum((v0[0] * v0[0] + v0[1] * v0[1]) + (v0[2] * v0[2] + v0[3] * v0[3]) + (v1[0] * v1[0] + v1[1] * v1[1]) + (v1[2] * v1[2] + v1[3] * v1[3])) * (1.f / 512.f);
            const float rstd = 1.0f / sqrtf(var + EPS);
            f32x4 o0, o1;
#pragma unroll
            for (int i = 0; i < 4; ++i) { const float y0 = v0[i] * rstd * g0[i] + b0[i], y1 = v1[i] * rstd * g1[i] + b1[i]; o0[i] = y0 * sigm(y0); o1[i] = y1 * sigm(y1); }
            store8(p.AACT + (size_t)(R0 + tok) * 512 + 8 * lane, o0, o1);
        }
        __syncthreads();
    }
}

__device__ __forceinline__ void phase_convb(const C1P& p, const Ctx& c) {
    const long gt = (long)c.gw * 64 + c.lane, NT = (long)c.NGW * 64;
    const int c8 = (int)(gt & 63) * 8;
    f32x4 w0[2], w1[2], w2[2];
#pragma unroll
    for (int hh = 0; hh < 2; ++hh) {
        w0[hh] = *(const f32x4*)(p.conv_b_w + ((size_t)p.l * 3 + 0) * 512 + c8 + 4 * hh);
        w1[hh] = *(const f32x4*)(p.conv_b_w + ((size_t)p.l * 3 + 1) * 512 + c8 + 4 * hh);
        w2[hh] = *(const f32x4*)(p.conv_b_w + ((size_t)p.l * 3 + 2) * 512 + c8 + 4 * hh);
    }
    for (long i = gt; i < (long)(M / 8) * 64; i += NT) {
        const int r0 = (int)(i >> 6) * 8;
        u32x4 xw[10], bw[8];
        f32x4 h0[2], h1[2];
        const bool smp = r0 >= MP, seq0 = (r0 & (SEQ - 1)) == 0;
#pragma unroll
        for (int k = 0; k < 8; ++k) { xw[2 + k] = *(const u32x4*)(p.CGH + (size_t)(r0 + k) * 512 + c8); bw[k] = *(const u32x4*)(p.BG + (size_t)(r0 + k) * 512 + c8); }
        if (smp) {
            const float* st = p.state_b + ((size_t)p.l * DECB + ((r0 - MP) >> 3)) * 2 * 512 + c8;
            h0[0] = *(const f32x4*)st; h0[1] = *(const f32x4*)(st + 4); h1[0] = *(const f32x4*)(st + 512); h1[1] = *(const f32x4*)(st + 512 + 4);
        } else if (!seq0) {
            xw[0] = *(const u32x4*)(p.CGH + (size_t)(r0 - 2) * 512 + c8); xw[1] = *(const u32x4*)(p.CGH + (size_t)(r0 - 1) * 512 + c8);
        }
        f32x4 x[10][2];
#pragma unroll
        for (int k = 2; k < 10; ++k) { x[k][0] = (f32x4){bflo(xw[k].x), bfhi(xw[k].x), bflo(xw[k].y), bfhi(xw[k].y)}; x[k][1] = (f32x4){bflo(xw[k].z), bfhi(xw[k].z), bflo(xw[k].w), bfhi(xw[k].w)}; }
        if (smp) { x[0][0] = h0[0]; x[0][1] = h0[1]; x[1][0] = h1[0]; x[1][1] = h1[1]; }
        else if (!seq0) {
#pragma unroll
            for (int k = 0; k < 2; ++k) { x[k][0] = (f32x4){bflo(xw[k].x), bfhi(xw[k].x), bflo(xw[k].y), bfhi(xw[k].y)}; x[k][1] = (f32x4){bflo(xw[k].z), bfhi(xw[k].z), bflo(xw[k].w), bfhi(xw[k].w)}; }
        } else { const f32x4 z4 = {0.f, 0.f, 0.f, 0.f}; x[0][0] = z4; x[0][1] = z4; x[1][0] = z4; x[1][1] = z4; }
#pragma unroll
        for (int k = 0; k < 8; ++k) {
            const f32x4 bg0 = {bflo(bw[k].x), bfhi(bw[k].x), bflo(bw[k].y), bfhi(bw[k].y)}, bg1 = {bflo(bw[k].z), bfhi(bw[k].z), bflo(bw[k].w), bfhi(bw[k].w)};
            const f32x4 o0 = bg0 * (w0[0] * x[k][0] + w1[0] * x[k + 1][0] + w2[0] * x[k + 2][0]), o1 = bg1 * (w0[1] * x[k][1] + w1[1] * x[k + 1][1] + w2[1] * x[k + 2][1]);
            store8(p.BG + (size_t)(r0 + k) * 512 + c8, o0, o1);
        }
    }
}

constexpr int VVT_LD = 136;
__device__ __forceinline__ void phase_gmlp(const C1P& p, LAS unsigned char* lds, const Ctx& c) {
    const int tid = c.tid, wid = c.wave, lane = c.lane, q = lane & 31, hi = lane >> 5;
    LAS bf16_t* VVt = (LAS bf16_t*)lds;
    for (int u = c.bid; u < 128 * 2; u += c.G) {
        const int ci = u >> 1, hh = u & 1, tok0 = ci * 128;
        {
            const int sb = tid & 15, db = tid >> 4;
            u32x4 vr[8], vo[8];
#pragma unroll
            for (int r8 = 0; r8 < 8; ++r8) vr[r8] = *(const u32x4*)(p.VV + (size_t)(tok0 + 8 * sb + r8) * 512 + 256 * hh + db * 8);
            transpose8x8(vr, vo);
#pragma unroll
            for (int j = 0; j < 8; ++j) *(LAS u32x4*)(VVt + (8 * db + j) * VVT_LD + 8 * sb) = vo[j];
        }
        __syncthreads();
        const int gl = wid >> 1, dt = wid & 1, g = 4 * hh + gl;
        const bf16_t* Wg = p.WSP + ((size_t)(p.l * 8 + g) * 128) * 128;
        const float* bs = p.b_sp + (size_t)(p.l * 8 + g) * 128;
#pragma unroll
        for (int ti = 0; ti < 4; ++ti) {
            f32x16 acc = (f32x16){0.f, 0.f, 0.f, 0.f, 0.f, 0.f, 0.f, 0.f, 0.f, 0.f, 0.f, 0.f, 0.f, 0.f, 0.f, 0.f};
            bf16x8 af[8];
#pragma unroll
            for (int ks = 0; ks < 2 * ti + 2; ++ks) af[ks] = *(const bf16x8*)(Wg + (size_t)(32 * ti + q) * 128 + 16 * ks + 8 * hi);
            bf16_t uu[16]; float bb[16];
#pragma unroll
            for (int r = 0; r < 16; ++r) { const int t = 32 * ti + crow(r, hi); uu[r] = p.U[(size_t)(tok0 + t) * 512 + g * 64 + 32 * dt + q]; bb[r] = bs[t]; }
#pragma unroll
            for (int ks = 0; ks < 2 * ti + 2; ++ks) {
                const bf16x8 bv = *(const LAS bf16x8*)(VVt + (gl * 64 + 32 * dt + q) * VVT_LD + 16 * ks + 8 * hi);
                acc = __builtin_amdgcn_mfma_f32_32x32x16_bf16(af[ks], bv, acc, 0, 0, 0);
            }
#pragma unroll
            for (int r = 0; r < 16; ++r) {
                const int t = 32 * ti + crow(r, hi);
                p.U[(size_t)(tok0 + t) * 512 + g * 64 + 32 * dt + q] = f2bf(bf2f(uu[r]) * (acc[r] + bb[r]));
            }
        }
        __syncthreads();
    }
    const long gt = (long)c.gw * 64 + c.lane, NT = (long)c.NGW * 64;
    for (long i = gt; i < (long)DECB * 512; i += NT) {
        const int b = (int)(i >> 9), ch = (int)(i & 511), g = ch >> 6;
        const float* Wg = p.w_sp + ((size_t)(p.l * 8 + g) * 128) * 128;
        const float* bs = p.b_sp + (size_t)(p.l * 8 + g) * 128;
        float vv[8];
#pragma unroll
        for (int s = 0; s < 8; ++s) vv[s] = bf2f(p.VV[((size_t)MP + b * 8 + s) * 512 + ch]);
#pragma unroll
        for (int t = 0; t < 8; ++t) {
            float z = bs[t];
#pragma unroll
            for (int s = 0; s <= t; ++s) z += Wg[t * 128 + s] * vv[s];
            bf16_t* up = p.U + ((size_t)MP + b * 8 + t) * 512 + ch;
            *up = f2bf(bf2f(*up) * z);
        }
    }
}

#ifndef KMASK
#define KMASK 0xFFFF
#endif
#define KEN(k) ((KMASK >> (k)) & 1)
enum { I_XP = 0, I_XS, I_CP, I_CS, I_STA, I_STB, I_CK, I_CV, I_WADA, I_BADA, I_N1G, I_N2G, I_WIN, I_QNG, I_KNG, I_SINK, I_WAO, I_CAW, I_CAB, I_LAG, I_LAB,
       I_WAOUT, I_CBW, I_WBOUT, I_LCG, I_LCB, I_WSP, I_BSP, I_WCOUT, I_WO, I_WUP, I_WDN };

typedef const __attribute__((address_space(4))) Args* ArgsP;
__device__ __forceinline__ ArgsP get_args() { ArgsP ap = (ArgsP)__builtin_amdgcn_kernarg_segment_ptr(); asm volatile("" : "+s"(ap)); return ap; }
#define WSB(off) ((bf16_t*)(ws + (off)))
__device__ __forceinline__ C1P make_c1p(ArgsP a, int l) {
    unsigned char* ws = a->ws;
    C1P p{WSB(WS_Q), WSB(WS_BG), WSB(WS_U), WSB(WS_AACT), WSB(WS_KV), WSB(WS_GLU), WSB(WS_CGH), WSB(WS_VV), WSB(WS_WSP), a->in[I_SINK] + l * 16, a->in[I_CK], a->in[I_CV], a->in[I_STA], a->in[I_STB],
          a->in[I_CAW], a->in[I_CAB], a->in[I_LAG], a->in[I_LAB], a->in[I_CBW], a->in[I_WSP], a->in[I_BSP], l, a->in[I_QNG] + l * 64, a->out};
    return p;
}

__global__ void __launch_bounds__(NTHR, 2) mega_fwd(Args a_unused) {
    extern __shared__ __attribute__((aligned(16))) unsigned char lds_raw[];
    LAS unsigned char* lds = (LAS unsigned char*)lds_raw;
    cg::grid_group grid = cg::this_grid();
    const int nprog = get_args()->nprog;
    volatile LAS unsigned* MISC = (volatile LAS unsigned*)(lds + BAR_LDS_OFF);
    if (threadIdx.x < 16) MISC[threadIdx.x] = 0u;
    __syncthreads();
    const XcdBarrier bar = xcd_barrier_post((unsigned*)get_args()->ws, MISC);

    for (int pi = 0; pi < nprog; ++pi) {
        const int ph = get_args()->prog[pi];
        const Ctx c = make_ctx();
        LAS float* scr = (LAS float*)(lds + c.wave * 16384);
        const int l = ph < 2 ? 0 : (ph - 2) / 9, kind = ph == 255 ? 99 : (ph < 2 ? ph : 2 + (ph - 2) % 9);
        switch (kind) {
        case 0: if (KEN(0)) {
            ArgsP a = get_args(); unsigned char* ws = a->ws;
            { int tb = 0; for (int ll = 0; ll < NL; ++ll) tb = transpose_tiles(a->in[I_WADA] + (size_t)ll * D * 6144, D, 6144, WSB(WS_WADA), ll * 6144, 0, (LAS float*)lds, tb, c.bid, c.G, c.tid); }
            const long gt = (long)c.gw * 64 + c.lane, NT = (long)c.NGW * 64;
            bf16_t* CS = WSB(WS_CS); bf16_t* WSPB = WSB(WS_WSP);
            const float* cp = a->in[I_CP]; const float* csm = a->in[I_CS]; const float* wsp = a->in[I_WSP];
            for (long i = gt; i < 256 * 1024; i += NT) {
                const int r = (int)(i >> 10), col = (int)(i & 1023);
                float v = 0.f;
                if (r < 2) v = cp[r * D + col]; else if (r < NBROW) v = csm[(size_t)(r - 2) * D + col];
                CS[i] = f2bf(v * sigm(v));
            }
            for (long i = gt; i < (long)NL * 8 * 128 * 128; i += NT) {
                const int t = (int)(i >> 7) & 127, s = (int)i & 127;
                WSPB[i] = f2bf(s <= t ? wsp[i] : 0.f);
            }
        } break;
        case 1: if (KEN(1)) {
            ArgsP a = get_args(); unsigned char* ws = a->ws;
            pg8::Gemm g{WSB(WS_CS), WSB(WS_WADA), 256, MODLD, D, D, D}; pg8::StaticOrder S; S.init(256, MODLD, c.G, c.bid);
            epi::EpiMod E{(float*)(ws + WS_MOD), a->in[I_BADA]};
            pg8::gemm_phase<epi::EpiMod, pg8::StaticOrder, false, true>(lds, g, S, E, c.tid);
            if (c.bid >= 48) {
                int tb = 0; const int b2 = c.bid - 48, G2 = c.G - 48;
                { ArgsP a2 = get_args(); unsigned char* ws = a2->ws; tb = transpose_tiles(a2->in[I_WIN], D, NIN, WSB(WS_WIN), 0, 1, (LAS float*)lds, tb, b2, G2, c.tid); }
                { ArgsP a2 = get_args(); unsigned char* ws = a2->ws; tb = transpose_tiles(a2->in[I_WAO], D, D, WSB(WS_WAO), 0, 0, (LAS float*)lds, tb, b2, G2, c.tid); }
                { ArgsP a2 = get_args(); unsigned char* ws = a2->ws; tb = transpose_tiles(a2->in[I_WAOUT], 512, D, WSB(WS_WA), 0, 0, (LAS float*)lds, tb, b2, G2, c.tid); }
                { ArgsP a2 = get_args(); unsigned char* ws = a2->ws; tb = transpose_tiles(a2->in[I_WBOUT], 512, D, WSB(WS_WB), 0, 0, (LAS float*)lds, tb, b2, G2, c.tid); }
                { ArgsP a2 = get_args(); unsigned char* ws = a2->ws; tb = transpose_tiles(a2->in[I_WCOUT], 512, D, WSB(WS_WC), 0, 0, (LAS float*)lds, tb, b2, G2, c.tid); }
                { ArgsP a2 = get_args(); unsigned char* ws = a2->ws; tb = transpose_tiles(a2->in[I_WO], D, D, WSB(WS_WO), 0, 0, (LAS float*)lds, tb, b2, G2, c.tid); }
            }
        } break;
        case 2: if (KEN(2)) {
            if (l > 0) {
            int tb = 0;
            { ArgsP a = get_args(); unsigned char* ws = a->ws; tb = transpose_tiles(a->in[I_WIN] + (size_t)l * D * NIN, D, NIN, WSB(WS_WIN), 0, 1, (LAS float*)lds, tb, c.bid, c.G, c.tid); }
            { ArgsP a = get_args(); unsigned char* ws = a->ws; tb = transpose_tiles(a->in[I_WAO] + (size_t)l * D * D, D, D, WSB(WS_WAO), 0, 0, (LAS float*)lds, tb, c.bid, c.G, c.tid); }
            { ArgsP a = get_args(); unsigned char* ws = a->ws; tb = transpose_tiles(a->in[I_WAOUT] + (size_t)l * 512 * D, 512, D, WSB(WS_WA), 0, 0, (LAS float*)lds, tb, c.bid, c.G, c.tid); }
            { ArgsP a = get_args(); unsigned char* ws = a->ws; tb = transpose_tiles(a->in[I_WBOUT] + (size_t)l * 512 * D, 512, D, WSB(WS_WB), 0, 0, (LAS float*)lds, tb, c.bid, c.G, c.tid); }
            { ArgsP a = get_args(); unsigned char* ws = a->ws; tb = transpose_tiles(a->in[I_WCOUT] + (size_t)l * 512 * D, 512, D, WSB(WS_WC), 0, 0, (LAS float*)lds, tb, c.bid, c.G, c.tid); }
            { ArgsP a = get_args(); unsigned char* ws = a->ws; tb = transpose_tiles(a->in[I_WO] + (size_t)l * D * D, D, D, WSB(WS_WO), 0, 0, (LAS float*)lds, tb, c.bid, c.G, c.tid); }
            }
            { ArgsP a = get_args(); unsigned char* ws = a->ws; float* X = a->out;
              const float* md = (const float*)(ws + WS_MOD) + (size_t)l * 6144;
              const float* xp = l == 0 ? a->in[I_XP] : X; const float* xs = l == 0 ? a->in[I_XS] : X + (size_t)MP * D;
              adaln_rows(xp, xs, nullptr, WSB(WS_H), a->in[I_N1G] + l * D, md + 0 * D, md + 1 * D, c); }
        } break;
        case 3: if (KEN(3)) {
            ArgsP a = get_args(); unsigned char* ws = a->ws;
            pg8::Gemm g{WSB(WS_H), WSB(WS_WIN), M, NIN, D, D, D}; pg8::StaticOrder S; S.init(M, NIN, c.G, c.bid);
            epi::EpiIn E{WSB(WS_Q), WSB(WS_KV), WSB(WS_GLU), WSB(WS_BG), WSB(WS_CGH), WSB(WS_U), WSB(WS_VV), WSB(WS_G)};
            pg8::gemm_phase<epi::EpiIn, pg8::StaticOrder, true, true>(lds, g, S, E, c.tid);
        } break;
        case 4: if (KEN(4)) {
            ArgsP a = get_args(); unsigned char* ws = a->ws;
            C0P p{WSB(WS_Q), WSB(WS_KV), WSB(WS_VV), WSB(WS_GLU), WSB(WS_CGH), a->in[I_QNG] + l * 64, a->in[I_KNG] + l * 64, a->in[I_LCG] + l * 512, a->in[I_LCB] + l * 512, a->in[I_CK], a->in[I_CV], a->in[I_STA], a->out, l};
            phase_c0(p, c);
        } break;
        case 5: if (KEN(5)) {
#ifndef SMASK
#define SMASK 15
#endif
            if (SMASK & 1) { const Ctx c1 = make_ctx(); const C1P p = make_c1p(get_args(), l); phase_attn(p, lds, c1); }
            if (SMASK & 2) { const Ctx c1 = make_ctx(); const C1P p = make_c1p(get_args(), l); phase_conva(p, lds, c1); }
            if (SMASK & 4) { const Ctx c1 = make_ctx(); const C1P p = make_c1p(get_args(), l); phase_convb(p, c1); }
            if (SMASK & 8) { const Ctx c1 = make_ctx(); const C1P p = make_c1p(get_args(), l); phase_gmlp(p, lds, c1); }
        } break;
        case 6: if (KEN(6)) {
            const bool odd = (blockIdx.x & 1) != 0;
#pragma unroll 1
            for (int st = 0; st < 6; ++st) {
                const Ctx c = make_ctx();
                const int op = !odd ? st : (st == 0 ? 1 : st == 1 ? 0 : st == 5 ? 2 : st + 1);
                ArgsP a = get_args(); unsigned char* ws = a->ws;
                if (op == 0) {
                    pg8::Gemm g{WSB(WS_Q), WSB(WS_WAO), MP, D, D, D, D}; pg8::StaticOrder S; S.init(MP, D, c.G, c.bid);
                    epi::EpiBranch E{WSB(WS_MG), (const unsigned char*)(ws + WS_G), 0};
                    pg8::gemm_phase<epi::EpiBranch, pg8::StaticOrder, true, true>(lds, g, S, E, c.tid);
                } else if (op == 2) {
                    pg8::Gemm g{WSB(WS_AACT), WSB(WS_WA), MP, D, 512, 512, 512};
                    epi::BranchOrder S; S.so.init(MP, D, c.G, c.bid);
                    S.A0 = WSB(WS_AACT); S.A1 = WSB(WS_BG); S.A2 = WSB(WS_U); S.B0 = WSB(WS_WA); S.B1 = WSB(WS_WB); S.B2 = WSB(WS_WC);
                    epi::EpiBranch E{WSB(WS_MG), (const unsigned char*)(ws + WS_G), 1};
                    pg8::gemm_phase<epi::EpiBranch, epi::BranchOrder, true, true>(lds, g, S, E, c.tid);
                } else {
                    const int br = op == 1 ? 0 : op - 2;
                    const bf16_t* A = br == 0 ? WSB(WS_Q) : br == 1 ? WSB(WS_AACT) : br == 2 ? WSB(WS_BG) : WSB(WS_U);
                    const bf16_t* Bt = br == 0 ? WSB(WS_WAO) : br == 1 ? WSB(WS_WA) : br == 2 ? WSB(WS_WB) : WSB(WS_WC);
                    const int K = br == 0 ? 1024 : 512;
                    EpiSBranch ES{WSB(WS_MG), (const unsigned char*)(ws + WS_G) + br * 1024, br == 0 ? 1 : 0};
                    small_gemm(lds, A + (size_t)MP * K, K, Bt, K, K, D, ES, c);
                }
            }
        } break;
        case 7: case 10: if (KEN(7)) {
            const bool dn = kind == 10;
#pragma unroll 1
            for (int st = 0; st < 2; ++st) {
                const Ctx c = make_ctx();
                ArgsP a = get_args(); unsigned char* ws = a->ws;
                const int K = dn ? FF : D;
                const bf16_t* A = dn ? WSB(WS_G) : WSB(WS_MG); const bf16_t* Bt = dn ? WSB(WS_WDN) : WSB(WS_WO);
                const float* gate = (const float*)(ws + WS_MOD) + (size_t)l * 6144 + (dn ? 5 : 2) * D;
                if ((st ^ (c.bid & 1)) == 0) {
                    pg8::Gemm g{A, Bt, MP, D, K, K, K}; pg8::StaticOrder S; S.init(MP, D, c.G, c.bid);
                    epi::EpiRes E{a->out, gate, (!dn && l == 0) ? a->in[I_XP] : (const float*)a->out};
                    pg8::gemm_phase<epi::EpiRes, pg8::StaticOrder, true, true>(lds, g, S, E, c.tid);
                } else {
                    EpiSRes ES{a->out, gate, (!dn && l == 0) ? a->in[I_XS] : (const float*)a->out + (size_t)MP * D};
                    small_gemm(lds, A + (size_t)MP * K, K, Bt, K, K, D, ES, c);
                }
            }
        } break;
        case 8: if (KEN(8)) {
            if (true) {
            int tb = 0;
            { ArgsP a = get_args(); unsigned char* ws = a->ws; tb = transpose_tiles(a->in[I_WUP] + (size_t)l * D * FF, D, FF, WSB(WS_WUP), 0, 0, (LAS float*)lds, tb, c.bid, c.G, c.tid); }
            { ArgsP a = get_args(); unsigned char* ws = a->ws; tb = transpose_tiles(a->in[I_WDN] + (size_t)l * FF * D, FF, D, WSB(WS_WDN), 0, 0, (LAS float*)lds, tb, c.bid, c.G, c.tid); }
            }
            { ArgsP a = get_args(); unsigned char* ws = a->ws; float* X = a->out;
              const float* md = (const float*)(ws + WS_MOD) + (size_t)l * 6144;
              adaln_rows(X, X + (size_t)MP * D, nullptr, WSB(WS_H), a->in[I_N2G] + l * D, md + 3 * D, md + 4 * D, c); }
        } break;
        case 9: if (KEN(9)) {
            ArgsP a = get_args(); unsigned char* ws = a->ws;
            pg8::Gemm g{WSB(WS_H), WSB(WS_WUP), MP, FF, D, D, D}; pg8::StaticOrder S; S.init(MP, FF, c.G, c.bid);
            epi::EpiUp E{WSB(WS_G), FF};
            pg8::gemm_phase<epi::EpiUp, pg8::StaticOrder, true, true>(lds, g, S, E, c.tid);
            EpiSUp ES{WSB(WS_G)};
            small_gemm(lds, WSB(WS_H) + (size_t)MP * D, D, WSB(WS_WUP), D, D, FF, ES, c);
        } break;
        default: break;
        }
        if (pi + 1 < nprog) { if (nprog > 200) grid.sync(); xcd_barrier(bar); }
    }
}

constexpr int NPHASES = 2 + 9 * NL;

extern "C" void kernel_launch(void* const* d_in, const int* in_sizes, int n_in, void* d_out, int out_size, void* d_ws, size_t ws_size, hipStream_t stream) {
    static int grid = 0;
    if (grid == 0) {
        if (n_in != 32 || ws_size < WS_END) { fprintf(stderr, "kernel_launch: unexpected n_in %d / ws_size %zu (need %zu)\n", n_in, ws_size, (size_t)WS_END); grid = -1; return; }
        int dev = 0, cus = 0, per_cu = 0;
        hipGetDevice(&dev); hipDeviceGetAttribute(&cus, hipDeviceAttributeMultiprocessorCount, dev);
        hipFuncSetAttribute((const void*)mega_fwd, hipFuncAttributeMaxDynamicSharedMemorySize, LDS_BYTES);
        hipOccupancyMaxActiveBlocksPerMultiprocessor(&per_cu, (const void*)mega_fwd, NTHR, LDS_BYTES);
        (void)hipGetLastError();
        if (per_cu < 1) per_cu = 1;
        grid = cus * per_cu;
    }
    if (grid < 0) return;
    Args a{};
    for (int i = 0; i < 32; ++i) a.in[i] = (const float*)d_in[i];
    a.out = (float*)d_out; a.ws = (unsigned char*)d_ws;
    int n = 0;
#ifndef PROBE
#define PROBE 0
#endif
    for (int ph = 0; ph < NPHASES; ++ph) {
        const int k = ph < 2 ? ph : 2 + (ph - 2) % 9;
        a.prog[n++] = (unsigned char)ph;
        if (PROBE == 1 && (k == 3 || k == 6 || k == 9)) a.prog[n++] = (unsigned char)ph;
        if (PROBE == 2 && (k == 2 || k == 8)) a.prog[n++] = (unsigned char)ph;
        if (PROBE == 2 && k == 1) { a.prog[n++] = 0; a.prog[n++] = 1; }
        if (PROBE == 3 && k == 5) { a.prog[n++] = (unsigned char)(ph - 3); a.prog[n++] = (unsigned char)(ph - 2); a.prog[n++] = (unsigned char)(ph - 1); a.prog[n++] = (unsigned char)ph; }
        if (PROBE == 4) a.prog[n++] = 255;
    }
    a.nprog = n;
    (void)hipMemsetAsync(d_ws, 0, BAR_BYTES, stream);
    void* args[] = {&a};
    hipError_t e = hipLaunchCooperativeKernel((const void*)mega_fwd, dim3(grid), dim3(NTHR), args, LDS_BYTES, stream);
    if (e != hipSuccess) fprintf(stderr, "cooperative launch failed: %s (grid %d)\n", hipGetErrorString(e), grid);
}
```

```cpp
#include <hip/hip_runtime.h>
#include <hip/hip_cooperative_groups.h>
#include <cstdio>
#include <cstdint>
namespace cg = cooperative_groups;
namespace pg8 {
#define PG8_LAS __attribute__((address_space(3)))
typedef unsigned short bf16_t;
typedef short bf16x8 __attribute__((ext_vector_type(8)));
typedef float f32x4 __attribute__((ext_vector_type(4)));
typedef unsigned u32x4 __attribute__((ext_vector_type(4)));
constexpr int BM = 256, BK = 64, HALF = 128, HTB = HALF * BK * 2  , STAGE_BYTES = 8 * HTB, NXCD = 8, WGM = 8;

__host__ __device__ __forceinline__ int lds_byte(int r, int c) { const int st = (r >> 4) * 2 + (c >> 5), rr = r & 15, cc = c & 31, ob = rr * 64 + cc * 2; return st * 1024 + (ob ^ (((ob >> 9) & 1) << 5)); }
__host__ __device__ __forceinline__ void stage_rc(int b, int& R, int& C) { const int st = b / 1024, sb = b % 1024, swz = sb ^ (((sb >> 9) & 1) << 5); R = (st >> 1) * 16 + swz / 64; C = (st & 1) * 32 + (swz % 64) / 2; }
__host__ __device__ __forceinline__ int perm32(int rho) { const int n = rho >> 4, i = rho & 15; return 8 * (i >> 2) + 4 * n + (i & 3); }

struct Unit { int pm, pn, aux; };
struct Gemm { const bf16_t* A; const bf16_t* Bt; int M, N, K, lda, ldb; };

struct StaticOrder {
    int nM, nN, nwg, G, c;
    __host__ __device__ void init(int M, int N, int G_, int c_) { nM = M / BM; nN = N / BM; nwg = nM * nN; G = G_; c = c_; }
    __host__ __device__ bool next(int i, Unit& u) const {
        const long L = (long)i * G + c; if (L >= nwg) return false;
        int wgid = (int)L; { const int q = nwg / NXCD, r = nwg % NXCD, xcd = wgid % NXCD, off = wgid / NXCD; wgid = (xcd < r ? xcd * (q + 1) : r * (q + 1) + (xcd - r) * q) + off; }
        const int nig = WGM * nN, gid = wgid / nig, fm = gid * WGM, gsz = (nM - fm) < WGM ? (nM - fm) : WGM;
        u.pm = fm + ((wgid % nig) % gsz); u.pn = (wgid % nig) / gsz; u.aux = 0; return true;
    }
    template <class G_> __device__ __forceinline__ const bf16_t* opA(const Unit&, const G_& g) const { return g.A; }
    template <class G_> __device__ __forceinline__ const bf16_t* opB(const Unit&, const G_& g) const { return g.Bt; }
    __device__ __forceinline__ void a_ready(const Unit&) const {}
    __device__ __forceinline__ void done(const Unit&) const {}
};
__device__ __forceinline__ unsigned cvt_pk_bf16(float lo, float hi) { unsigned r; asm volatile("v_cvt_pk_bf16_f32 %0, %1, %2" : "=v"(r) : "v"(lo), "v"(hi)); return r; }
typedef float f32x2 __attribute__((ext_vector_type(2)));
template <class Epi, class Sched, bool ALIGN_EPI = false, bool SP2 = false>
__device__ __forceinline__ void gemm_phase(PG8_LAS unsigned char* lds, const Gemm g, const Sched& S, const Epi& E, const int tid) {
    const int wid = __builtin_amdgcn_readfirstlane(tid >> 6), lane = tid & 63, wr = wid >> 2, wc = wid & 3, fr = lane & 15, fq = lane >> 4;
    const int K = g.K, nt = K / BK;
    unsigned voffA[2], voffB[2];
#pragma unroll
    for (int i = 0; i < 2; ++i) { int R, C; stage_rc(tid * 16 + i * 8192, R, C); const int Rb = Epi::PERM ? ((R & ~31) + perm32(R & 31)) : R;
        voffA[i] = (unsigned)(R * g.lda + C) * 2u; voffB[i] = (unsigned)(Rb * g.ldb + C) * 2u; }
    const size_t kstep = (size_t)(BK * 2);
    const size_t hstepA = (size_t)HALF * g.lda * 2, hstepB = (size_t)HALF * g.ldb * 2;
    const size_t tstepA = 2 * hstepA, tstepB = 2 * hstepB;
    const unsigned ldsw = (unsigned)wid * 1024u;
    const int aoff = lds_byte(wr * 64 + fr, fq * 8), boff = lds_byte(wc * 32 + fr, fq * 8);
#define PG8_SA(b, h) (((b) * 2 + (h)) * HTB)
#define PG8_SB(b, h) ((4 + (b) * 2 + (h)) * HTB)
#define PG8_STAGE(bufoff, gbase, voff) do { _Pragma("unroll") for (int _i = 0; _i < 2; ++_i) \
        __builtin_amdgcn_global_load_lds((const unsigned*)((const char*)(gbase) + (voff)[_i]), (PG8_LAS unsigned*)(lds + (bufoff) + ldsw + _i * 8192), 16, 0, 0); } while (0)
#define PG8_LDA(dst, b, h) do { _Pragma("unroll") for (int m = 0; m < 4; ++m) _Pragma("unroll") for (int k = 0; k < 2; ++k) dst[m][k] = *(const PG8_LAS bf16x8*)(lds + PG8_SA(b, h) + aoff + m * 2048 + k * 1024); } while (0)
#define PG8_LDB(dst, b, h) do { _Pragma("unroll") for (int n = 0; n < 2; ++n) _Pragma("unroll") for (int k = 0; k < 2; ++k) dst[n][k] = *(const PG8_LAS bf16x8*)(lds + PG8_SB(b, h) + boff + n * 2048 + k * 1024); } while (0)
#define PG8_MMA(ai, bj, At, Bt) do { __builtin_amdgcn_s_setprio(1); _Pragma("unroll") for (int m = 0; m < 4; ++m) _Pragma("unroll") for (int n = 0; n < 2; ++n) _Pragma("unroll") for (int k = 0; k < 2; ++k) \
        acc[ai][bj][m][n] = __builtin_amdgcn_mfma_f32_16x16x32_bf16(Bt[n][k], At[m][k], acc[ai][bj][m][n], 0, 0, 0); __builtin_amdgcn_s_setprio(0); } while (0)
#define PG8_WAIT_V(n) asm volatile("s_waitcnt vmcnt(" #n ")" ::: "memory")
#define PG8_WAIT_L(n) asm volatile("s_waitcnt lgkmcnt(" #n ")" ::: "memory")
#define PG8_BAR __builtin_amdgcn_s_barrier()
#define PG8_SCHED __builtin_amdgcn_sched_barrier(0)
    Unit cur, nxt; int ui = 0;
    if (!S.next(0, cur)) return;
    f32x4 acc[2][2][4][2];
#pragma unroll
    for (int a = 0; a < 2; ++a)
#pragma unroll
        for (int b = 0; b < 2; ++b)
#pragma unroll
            for (int m = 0; m < 4; ++m)
#pragma unroll
                for (int n = 0; n < 2; ++n) acc[a][b][m][n] = (f32x4){0.f, 0.f, 0.f, 0.f};
    bf16x8 At[4][2], B0[2][2], B1[2][2];
    const char* cA = (const char*)S.opA(cur, g) + (size_t)cur.pm * tstepA; const char* cB = (const char*)S.opB(cur, g) + (size_t)cur.pn * tstepB;
    S.a_ready(cur);
    if constexpr (SP2) {
        PG8_STAGE(PG8_SB(0, 0), cB, voffB); PG8_STAGE(PG8_SB(0, 1), cB + hstepB, voffB); PG8_STAGE(PG8_SA(0, 0), cA, voffA); PG8_STAGE(PG8_SA(0, 1), cA + hstepA, voffA);
        if (wr == 1) PG8_BAR;
        PG8_WAIT_V(2); PG8_BAR;
        PG8_STAGE(PG8_SB(1, 0), cB + kstep, voffB); PG8_STAGE(PG8_SA(1, 0), cA + kstep, voffA); PG8_STAGE(PG8_SB(1, 1), cB + hstepB + kstep, voffB);
        PG8_WAIT_V(6); PG8_BAR;
    } else {
        PG8_STAGE(PG8_SB(0, 0), cB, voffB); PG8_STAGE(PG8_SA(0, 0), cA, voffA); PG8_STAGE(PG8_SB(0, 1), cB + hstepB, voffB); PG8_STAGE(PG8_SA(0, 1), cA + hstepA, voffA);
        if (wr == 1) PG8_BAR;
        PG8_WAIT_V(4); PG8_BAR;
        PG8_STAGE(PG8_SB(1, 0), cB + kstep, voffB); PG8_STAGE(PG8_SA(1, 0), cA + kstep, voffA); PG8_STAGE(PG8_SB(1, 1), cB + hstepB + kstep, voffB);
        PG8_WAIT_V(6); PG8_BAR;
    }
    for (;;) {
        const bool has_next = S.next(ui + 1, nxt);
        const char* nA = has_next ? (const char*)S.opA(nxt, g) + (size_t)nxt.pm * tstepA : cA; const char* nB = has_next ? (const char*)S.opB(nxt, g) + (size_t)nxt.pn * tstepB : cB;
        for (int t = 0; t < nt; t += 2) {
            const bool last = (t == nt - 2);
            const char* a1 = cA + (size_t)(t + 1) * kstep;
            const char* a2 = last ? nA : cA + (size_t)(t + 2) * kstep; const char* b2 = last ? nB : cB + (size_t)(t + 2) * kstep;
            const char* a3 = a2 + kstep; const char* b3 = b2 + kstep;
            if (last && has_next) S.a_ready(nxt);
            if constexpr (SP2) {
            PG8_LDB(B0, 0, 0); PG8_LDB(B1, 0, 1); PG8_SCHED; PG8_LDA(At, 0, 0); PG8_STAGE(PG8_SA(1, 1), a1 + hstepA, voffA);
            PG8_WAIT_V(8); PG8_WAIT_L(0); PG8_BAR; PG8_MMA(0, 0, At, B0); PG8_MMA(0, 1, At, B1); PG8_BAR; PG8_SCHED;
            PG8_LDA(At, 0, 1); PG8_STAGE(PG8_SB(0, 0), b2, voffB); PG8_STAGE(PG8_SB(0, 1), b2 + hstepB, voffB); PG8_STAGE(PG8_SA(0, 0), a2, voffA);
            PG8_WAIT_V(8); PG8_WAIT_L(0); PG8_BAR; PG8_MMA(1, 0, At, B0); PG8_MMA(1, 1, At, B1); PG8_BAR; PG8_SCHED;
            PG8_LDB(B0, 1, 0); PG8_LDB(B1, 1, 1); PG8_SCHED; PG8_LDA(At, 1, 0); PG8_STAGE(PG8_SA(0, 1), a2 + hstepA, voffA);
            PG8_WAIT_V(8); PG8_WAIT_L(0); PG8_BAR; PG8_MMA(0, 0, At, B0); PG8_MMA(0, 1, At, B1); PG8_BAR; PG8_SCHED;
            PG8_LDA(At, 1, 1); PG8_STAGE(PG8_SB(1, 0), b3, voffB); PG8_STAGE(PG8_SB(1, 1), b3 + hstepB, voffB); PG8_STAGE(PG8_SA(1, 0), a3, voffA);
            PG8_WAIT_V(8); PG8_WAIT_L(0); PG8_BAR; PG8_MMA(1, 0, At, B0); PG8_MMA(1, 1, At, B1); PG8_BAR; PG8_SCHED;
            } else {
            PG8_LDB(B0, 0, 0); PG8_SCHED; PG8_LDA(At, 0, 0); PG8_STAGE(PG8_SA(1, 1), a1 + hstepA, voffA);
            PG8_WAIT_L(8); PG8_BAR; PG8_WAIT_L(0); PG8_MMA(0, 0, At, B0); PG8_BAR; PG8_SCHED;
            PG8_LDB(B1, 0, 1); PG8_STAGE(PG8_SB(0, 0), b2, voffB);
            PG8_BAR; PG8_WAIT_L(0); PG8_MMA(0, 1, At, B1); PG8_BAR;
            PG8_LDA(At, 0, 1); PG8_STAGE(PG8_SA(0, 0), a2, voffA);
            PG8_BAR; PG8_WAIT_L(0); PG8_MMA(1, 0, At, B0); PG8_BAR; PG8_SCHED;
            PG8_STAGE(PG8_SB(0, 1), b2 + hstepB, voffB);
            PG8_WAIT_V(6); PG8_BAR; PG8_MMA(1, 1, At, B1); PG8_BAR;
            PG8_LDB(B0, 1, 0); PG8_SCHED; PG8_LDA(At, 1, 0); PG8_STAGE(PG8_SA(0, 1), a2 + hstepA, voffA);
            PG8_WAIT_L(8); PG8_BAR; PG8_WAIT_L(0); PG8_MMA(0, 0, At, B0); PG8_BAR; PG8_SCHED;
            PG8_LDB(B1, 1, 1); PG8_STAGE(PG8_SB(1, 0), b3, voffB);
            PG8_BAR; PG8_WAIT_L(0); PG8_MMA(0, 1, At, B1); PG8_BAR;
            PG8_LDA(At, 1, 1); PG8_STAGE(PG8_SA(1, 0), a3, voffA);
            PG8_BAR; PG8_WAIT_L(0); PG8_MMA(1, 0, At, B0); PG8_BAR; PG8_SCHED;
            PG8_STAGE(PG8_SB(1, 1), b3 + hstepB, voffB);
            PG8_WAIT_V(6); PG8_BAR; PG8_MMA(1, 1, At, B1); PG8_BAR;
            }
        }
        if constexpr (ALIGN_EPI) { if (wr == 0) PG8_BAR; }
        if constexpr (!Epi::AFTER_DRAIN) { E(acc, cur, wr, wc, fr, fq); S.done(cur); }
        if (!has_next) break;
#pragma unroll
        for (int a = 0; a < 2; ++a)
#pragma unroll
            for (int b = 0; b < 2; ++b)
#pragma unroll
                for (int m = 0; m < 4; ++m)
#pragma unroll
                    for (int n = 0; n < 2; ++n) acc[a][b][m][n] = (f32x4){0.f, 0.f, 0.f, 0.f};
        cur = nxt; cA = nA; cB = nB; ++ui;
        if constexpr (ALIGN_EPI) { if (wr == 1) PG8_BAR; }
    }
    PG8_WAIT_V(0);
    if constexpr (!ALIGN_EPI) { if (wr == 0) PG8_BAR; }
    PG8_BAR;
    if constexpr (Epi::AFTER_DRAIN) { E.fused(acc, cur, wr, wc, fr, fq, lds, wid, lane); S.done(cur); }
#undef PG8_SA
#undef PG8_SB
#undef PG8_STAGE
#undef PG8_LDA
#undef PG8_LDB
#undef PG8_MMA
#undef PG8_WAIT_V
#undef PG8_WAIT_L
#undef PG8_BAR
#undef PG8_SCHED
}
}

#define LAS __attribute__((address_space(3)))
typedef pg8::bf16_t bf16_t;
typedef pg8::bf16x8 bf16x8;
typedef pg8::f32x4 f32x4;
typedef pg8::u32x4 u32x4;
typedef float f32x16 __attribute__((ext_vector_type(16)));
typedef float f32x2v __attribute__((ext_vector_type(2)));
typedef unsigned u32x2 __attribute__((ext_vector_type(2)));
typedef short s16x4 __attribute__((ext_vector_type(4)));

constexpr int D = 1024, SEQ = 8192, MP = 16384, MS = 1024, M = MP + MS, NL = 2, DECB = 128, DECT = 8;
constexpr int NIN = 9216, FF = 4096, NBROW = 130, MODLD = 12288;
constexpr float EPS = 1e-6f;
constexpr int NWAVES = 8, NTHR = 512;
constexpr int LDS_BYTES = 147456, BAR_LDS_OFF = 147456 - 256;
constexpr size_t BAR_BYTES = 16384;

constexpr size_t MiB = 1u << 20;
constexpr size_t WS_WIN = 1 * MiB, WS_WAO = 19 * MiB, WS_WA = 21 * MiB, WS_WB = 22 * MiB, WS_WC = 23 * MiB, WS_WO = 24 * MiB, WS_WSP = 26 * MiB;
constexpr size_t WS_MOD = 27 * MiB, WS_H = 39 * MiB, WS_G = 73 * MiB, WS_R1 = 209 * MiB;
constexpr size_t WS_Q = WS_R1, WS_KV = WS_Q + 34 * MiB, WS_GLU = WS_KV + 17 * MiB, WS_CGH = WS_GLU + 17 * MiB, WS_VV = WS_CGH + 17 * MiB, WS_BG = WS_VV + 17 * MiB, WS_U = WS_BG + 17 * MiB;
constexpr size_t WS_WUP = WS_U + 17 * MiB, WS_WDN = WS_WUP + 8 * MiB;
constexpr size_t WS_END = WS_WDN + 8 * MiB;
constexpr size_t WS_WADA = WS_G, WS_CS = WS_R1, WS_AACT = WS_H, WS_MG = WS_KV;

constexpr size_t O_PA = 17825792, O_SA = 17887232, O_PB = 21819392, O_SB = 21823488, O_PK = 22085632, O_SK = 22216704, O_PV = 30605312, O_SV = 30736384, O_SG = 39124992;

__device__ __forceinline__ unsigned cvtpk(float lo, float hi) { return pg8::cvt_pk_bf16(lo, hi); }
__device__ __forceinline__ float bflo(unsigned w) { return __uint_as_float(w << 16); }
__device__ __forceinline__ float bfhi(unsigned w) { return __uint_as_float(w & 0xffff0000u); }
__device__ __forceinline__ float bf2f(bf16_t h) { return __uint_as_float((unsigned)h << 16); }
__device__ __forceinline__ bf16_t f2bf(float f) { return (bf16_t)(cvtpk(f, 0.f) & 0xffffu); }
__device__ __forceinline__ float sigm(float x) { return __builtin_amdgcn_rcpf(1.f + __builtin_amdgcn_exp2f(-1.4426950408889634f * x)); }
__device__ __forceinline__ float gelu_t(float x) { const float u = 1.5957691216057308f * (x + 0.044715f * x * x * x); return x * sigm(u); }
__device__ __forceinline__ float wave_sum(float v) {
#pragma unroll
    for (int o = 1; o < 64; o <<= 1) v += __shfl_xor(v, o);
    return v;
}
__device__ __forceinline__ int bidx(int r) { return r < MP ? (r >> 13) : 2 + ((r - MP) >> 3); }
__device__ __forceinline__ int crow(int r, int hi) { return (r & 3) + 8 * (r >> 2) + 4 * hi; }
__device__ __forceinline__ void store8(bf16_t* p, f32x4 a, f32x4 b) {
    u32x4 w; w.x = cvtpk(a[0], a[1]); w.y = cvtpk(a[2], a[3]); w.z = cvtpk(b[0], b[1]); w.w = cvtpk(b[2], b[3]); *(u32x4*)p = w;
}

__device__ __forceinline__ unsigned q8(float s) { return (unsigned)(s * 255.f + 0.5f); }
__device__ __forceinline__ unsigned pack4_q8(float a, float b, float c, float d) { return q8(a) | (q8(b) << 8) | (q8(c) << 16) | (q8(d) << 24); }
__device__ __forceinline__ float ub(unsigned w, int k) { return (float)((w >> (8 * k)) & 0xffu) * (1.f / 255.f); }
namespace epi {
using namespace pg8;
struct BranchOrder {
    StaticOrder so; const bf16_t *A0, *A1, *A2, *B0, *B1, *B2;
    __device__ __forceinline__ bool next(int i, Unit& u) const { if (i >= 3) return false; Unit t; if (!so.next(0, t)) return false; u.pm = t.pm; u.pn = t.pn; u.aux = i; return true; }
    template <class G_> __device__ __forceinline__ const bf16_t* opA(const Unit& u, const G_&) const { return u.aux == 0 ? A0 : u.aux == 1 ? A1 : A2; }
    template <class G_> __device__ __forceinline__ const bf16_t* opB(const Unit& u, const G_&) const { return u.aux == 0 ? B0 : u.aux == 1 ? B1 : B2; }
    __device__ __forceinline__ void a_ready(const Unit&) const {}
    __device__ __forceinline__ void done(const Unit&) const {}
};
struct EpiIn {
    static constexpr bool PERM = true, AFTER_DRAIN = false;
    bf16_t *Q, *KV, *GLU, *BG, *CGH, *U, *VV, *G;
    __device__ __forceinline__ void operator()(const f32x4 (&acc)[2][2][4][2], const Unit& u, int wr, int wc, int fr, int fq) const {
        const int pn = u.pn;
        bf16_t* dst; int ld, c0, act = 0, pair = 0;
        if (pn < 4) { dst = Q; ld = 1024; c0 = 256 * pn; }
        else if (pn < 6) { dst = KV; ld = 512; c0 = 256 * (pn - 4); }
        else if (pn < 10) { dst = GLU; ld = 512; c0 = 128 * (pn - 6); pair = 1; }
        else if (pn < 12) { dst = BG; ld = 512; c0 = 256 * (pn - 10); }
        else if (pn < 16) { dst = CGH; ld = 512; c0 = 128 * (pn - 12); pair = 2; }
        else if (pn < 18) { dst = U; ld = 512; c0 = 256 * (pn - 16); act = 2; }
        else if (pn < 20) { dst = VV; ld = 512; c0 = 256 * (pn - 18); act = 2; }
        else { dst = G; ld = 4096; c0 = 256 * (pn - 20); act = 3; }
        const int row0 = u.pm * BM + wr * 64 + fr, col0 = c0 + wc * 32 + 8 * fq;
#pragma unroll
        for (int ai = 0; ai < 2; ++ai)
#pragma unroll
            for (int m = 0; m < 4; ++m) {
                bf16_t* rowp = dst + (size_t)(row0 + ai * HALF + m * 16) * ld + col0;
                if (pair) {
                    f32x4 a0 = acc[ai][0][m][0], a1 = acc[ai][0][m][1], g0 = acc[ai][1][m][0], g1 = acc[ai][1][m][1];
                    if (pair == 1) {
#pragma unroll
                        for (int i = 0; i < 4; ++i) { g0[i] = sigm(g0[i]); g1[i] = sigm(g1[i]); }
                    }
                    store8(rowp, a0 * g0, a1 * g1);
                } else {
#pragma unroll
                    for (int bj = 0; bj < 2; ++bj) {
                        f32x4 v0 = acc[ai][bj][m][0], v1 = acc[ai][bj][m][1];
                        if (act == 3) {
#pragma unroll
                            for (int i = 0; i < 4; ++i) { v0[i] = sigm(v0[i]); v1[i] = sigm(v1[i]); }
                            u32x2 w; w.x = pack4_q8(v0[0], v0[1], v0[2], v0[3]); w.y = pack4_q8(v1[0], v1[1], v1[2], v1[3]);
                            *(u32x2*)((unsigned char*)dst + (size_t)(row0 + ai * HALF + m * 16) * 4096 + col0 + bj * HALF) = w;
                            continue;
                        } else if (act == 2) {
#pragma unroll
                            for (int i = 0; i < 4; ++i) { v0[i] = gelu_t(v0[i]); v1[i] = gelu_t(v1[i]); }
                        }
                        store8(rowp + bj * HALF, v0, v1);
                    }
                }
            }
    }
};
struct EpiUp {
    static constexpr bool PERM = true, AFTER_DRAIN = false;
    bf16_t* O; int ld;
    __device__ __forceinline__ void operator()(const f32x4 (&acc)[2][2][4][2], const Unit& u, int wr, int wc, int fr, int fq) const {
        const int row0 = u.pm * BM + wr * 64 + fr, col0 = u.pn * BM + wc * 32 + 8 * fq;
#pragma unroll
        for (int ai = 0; ai < 2; ++ai)
#pragma unroll
            for (int m = 0; m < 4; ++m) {
                bf16_t* rowp = O + (size_t)(row0 + ai * HALF + m * 16) * ld + col0;
#pragma unroll
                for (int bj = 0; bj < 2; ++bj) {
                    f32x4 v0 = acc[ai][bj][m][0], v1 = acc[ai][bj][m][1];
#pragma unroll
                    for (int i = 0; i < 4; ++i) { const float a = fmaxf(v0[i], 0.f), b = fmaxf(v1[i], 0.f); v0[i] = a * a; v1[i] = b * b; }
                    store8(rowp + bj * HALF, v0, v1);
                }
            }
    }
};
struct EpiBranch {
    static constexpr bool PERM = true, AFTER_DRAIN = false;
    bf16_t* MG; const unsigned char* Gb; int br0;
    __device__ __forceinline__ void operator()(const f32x4 (&acc)[2][2][4][2], const Unit& u, int wr, int wc, int fr, int fq) const {
        const int row0 = u.pm * BM + wr * 64 + fr, col0 = u.pn * BM + wc * 32 + 8 * fq;
        const int br = br0 + u.aux; const bool first = br == 0; const unsigned char* Gt = Gb + br * 1024;
        u32x2 gw[2][4][2];
#pragma unroll
        for (int ai = 0; ai < 2; ++ai)
#pragma unroll
            for (int m = 0; m < 4; ++m)
#pragma unroll
                for (int bj = 0; bj < 2; ++bj) gw[ai][m][bj] = *(const u32x2*)(Gt + (size_t)(row0 + ai * HALF + m * 16) * 4096 + col0 + bj * HALF);
#pragma unroll
        for (int ai = 0; ai < 2; ++ai) {
            u32x4 mw[4][2];
#pragma unroll
            for (int m = 0; m < 4; ++m)
#pragma unroll
                for (int bj = 0; bj < 2; ++bj) {
                    const size_t r = (size_t)(row0 + ai * HALF + m * 16); const int c = col0 + bj * HALF;
                    if (!first) mw[m][bj] = *(const u32x4*)(MG + r * 1024 + c); else mw[m][bj] = (u32x4){0u, 0u, 0u, 0u};
                }
#pragma unroll
            for (int m = 0; m < 4; ++m)
#pragma unroll
                for (int bj = 0; bj < 2; ++bj) {
                    const size_t r = (size_t)(row0 + ai * HALF + m * 16); const int c = col0 + bj * HALF;
                    const u32x2 g = gw[ai][m][bj]; const u32x4 o = mw[m][bj];
                    f32x4 v0 = acc[ai][bj][m][0], v1 = acc[ai][bj][m][1];
                    v0[0] = v0[0] * ub(g.x, 0) + bflo(o.x); v0[1] = v0[1] * ub(g.x, 1) + bfhi(o.x); v0[2] = v0[2] * ub(g.x, 2) + bflo(o.y); v0[3] = v0[3] * ub(g.x, 3) + bfhi(o.y);
                    v1[0] = v1[0] * ub(g.y, 0) + bflo(o.z); v1[1] = v1[1] * ub(g.y, 1) + bfhi(o.z); v1[2] = v1[2] * ub(g.y, 2) + bflo(o.w); v1[3] = v1[3] * ub(g.y, 3) + bfhi(o.w);
                    store8(MG + r * 1024 + c, v0, v1);
                }
        }
    }
};
struct EpiRes {
    static constexpr bool PERM = false, AFTER_DRAIN = false;
    float* X; const float* gate; const float* base;
    __device__ __forceinline__ void operator()(const f32x4 (&acc)[2][2][4][2], const Unit& u, int wr, int wc, int fr, int fq) const {
        const int row0 = u.pm * BM + wr * 64 + fr, col0 = u.pn * BM + wc * 32 + 4 * fq;
        const float* gp = gate + (size_t)bidx(u.pm * BM) * MODLD + col0;
        f32x4 g[2][2];
#pragma unroll
        for (int bj = 0; bj < 2; ++bj)
#pragma unroll
            for (int n = 0; n < 2; ++n) g[bj][n] = *(const f32x4*)(gp + bj * HALF + n * 16);
#pragma unroll
        for (int ai = 0; ai < 2; ++ai) {
            f32x4 x[4][2][2];
#pragma unroll
            for (int m = 0; m < 4; ++m)
#pragma unroll
                for (int bj = 0; bj < 2; ++bj)
#pragma unroll
                    for (int n = 0; n < 2; ++n) x[m][bj][n] = *(const f32x4*)(base + (size_t)(row0 + ai * HALF + m * 16) * 1024 + col0 + bj * HALF + n * 16);
#pragma unroll
            for (int m = 0; m < 4; ++m)
#pragma unroll
                for (int bj = 0; bj < 2; ++bj)
#pragma unroll
                    for (int n = 0; n < 2; ++n)
                        *(f32x4*)(X + (size_t)(row0 + ai * HALF + m * 16) * 1024 + col0 + bj * HALF + n * 16) = x[m][bj][n] + g[bj][n] * acc[ai][bj][m][n];
        }
    }
};
struct EpiMod {
    static constexpr bool PERM = false, AFTER_DRAIN = false;
    float* O; const float* bias;
    __device__ __forceinline__ void operator()(const f32x4 (&acc)[2][2][4][2], const Unit& u, int wr, int wc, int fr, int fq) const {
        const int row0 = u.pm * BM + wr * 64 + fr, col0 = u.pn * BM + wc * 32 + 4 * fq;
#pragma unroll
        for (int ai = 0; ai < 2; ++ai)
#pragma unroll
            for (int m = 0; m < 4; ++m) {
                const int r = row0 + ai * HALF + m * 16;
                if (r < NBROW) {
#pragma unroll
                    for (int bj = 0; bj < 2; ++bj)
#pragma unroll
                        for (int n = 0; n < 2; ++n) {
                            const int c = col0 + bj * HALF + n * 16;
                            *(f32x4*)(O + (size_t)r * MODLD + c) = acc[ai][bj][m][n] + *(const f32x4*)(bias + c);
                        }
                }
            }
    }
};
}


#define RLX_AGENT __ATOMIC_RELAXED, __HIP_MEMORY_SCOPE_AGENT
#define LDS_WAIT() asm volatile("s_waitcnt lgkmcnt(0)" ::: "memory")
#define VM_WAIT() asm volatile("s_waitcnt vmcnt(0)" ::: "memory")
__device__ __forceinline__ unsigned long long rt() { return __builtin_amdgcn_s_memrealtime(); }
#define XB_TMO      128
#define XB_XCNT(j)  (256  + 64 * (j))
#define XB_XSUB(j)  (1280 + 64 * (j))
#define XB_XGEN(j)  (2304 + 64 * (j))
#define XB_TOP      3328
#define XB_TOPGEN   3392
#define XCD_BAR_WORDS 3456
#define XB_SPIN_CAP (1u << 18)

__device__ __forceinline__ unsigned xb_ld(unsigned* p)              { return __hip_atomic_load(p, __ATOMIC_RELAXED, __HIP_MEMORY_SCOPE_AGENT); }
__device__ __forceinline__ unsigned xb_add(unsigned* p, unsigned v) { return __hip_atomic_fetch_add(p, v, __ATOMIC_RELAXED, __HIP_MEMORY_SCOPE_AGENT); }
__device__ __forceinline__ unsigned xb_xcc_id() { return (unsigned)__builtin_amdgcn_s_getreg((3 << 11) | 20) & 0xFu; }
#define XB_SPIN(cond, bar) do { unsigned _sp = 0; while (cond) { __builtin_amdgcn_s_sleep(1); \
    if ((++_sp & 255u) == 0u) { if (xb_ld(&(bar)[XB_TMO])) break; if (_sp > XB_SPIN_CAP) { atomicAdd(&(bar)[XB_TMO], 1u); break; } } } } while (0)

struct XcdBarrier {
    unsigned* bar; unsigned x;
    volatile LAS unsigned* st;
};

__device__ __forceinline__ XcdBarrier xcd_barrier_post(unsigned* bar, volatile LAS unsigned* st) {
    XcdBarrier b; b.bar = bar; b.x = xb_xcc_id(); b.st = st;
    if (threadIdx.x == 0) (void)xb_add(&bar[XB_XCNT(b.x)], 1u);
    return b;
}
__device__ __forceinline__ void xcd_barrier_complete(unsigned* bar, unsigned x, unsigned& nloc, unsigned& nx) {
    const unsigned G = gridDim.x * gridDim.y * gridDim.z;
    unsigned sum, cnt, mine, sp = 0u;
    for (;;) {
        sum = 0u; cnt = 0u; mine = 0u;
#pragma unroll
        for (unsigned j = 0; j < 16; ++j) { const unsigned c = xb_ld(&bar[XB_XCNT(j)]); sum += c; cnt += (c > 0u) ? 1u : 0u; mine = (j == x) ? c : mine; }
        if (sum == G) break;
        __builtin_amdgcn_s_sleep(1);
        if ((++sp & 255u) == 0u) { if (xb_ld(&bar[XB_TMO])) break; if (sp > XB_SPIN_CAP) { atomicAdd(&bar[XB_TMO], 1u); break; } }
    }
    nloc = mine > 0u ? mine : 1u; nx = cnt > 0u ? cnt : 1u;
}

__device__ __forceinline__ void xcd_barrier(const XcdBarrier& b) {
    asm volatile("s_waitcnt vmcnt(0)" ::: "memory");
    __syncthreads();
    if (threadIdx.x == 0) {
        unsigned* bar = b.bar;
        __builtin_amdgcn_s_waitcnt(0);
        unsigned nloc = b.st[0], nx = b.st[1];
        if (nloc == 0u) { xcd_barrier_complete(bar, b.x, nloc, nx); b.st[0] = nloc; b.st[1] = nx; }
        const unsigned old = xb_add(&bar[XB_XSUB(b.x)], 1u);
        const unsigned gen = old / nloc;
        if (old + 1u == (gen + 1u) * nloc) {
            __builtin_amdgcn_fence(__ATOMIC_RELEASE, "agent");
            asm volatile("s_waitcnt vmcnt(0)" ::: "memory");
            const unsigned og = xb_add(&bar[XB_TOP], 1u);
            const unsigned tg = og / nx;
            if (og + 1u == (tg + 1u) * nx) xb_add(&bar[XB_TOPGEN], 1u);
            else XB_SPIN(xb_ld(&bar[XB_TOPGEN]) == tg, bar);
            __builtin_amdgcn_fence(__ATOMIC_ACQUIRE, "agent");
            xb_add(&bar[XB_XGEN(b.x)], 1u);
            asm volatile("s_waitcnt vmcnt(0)" ::: "memory");
        } else {
            XB_SPIN(xb_ld(&bar[XB_XGEN(b.x)]) == gen, bar);
            __builtin_amdgcn_fence(__ATOMIC_ACQUIRE, "agent");
            asm volatile("s_waitcnt vmcnt(0)" ::: "memory");
        }
    }
    __syncthreads();
}

struct Args {
    const float* in[32]; float* out; unsigned char* ws; int nprog; unsigned char prog[60];
};

struct Ctx { int tid, lane, wave, gw, NGW, bid, G; };
__device__ __forceinline__ Ctx make_ctx() {
    int tid = threadIdx.x; asm volatile("" : "+v"(tid));
    int bid = blockIdx.x; asm volatile("" : "+s"(bid));
    Ctx c; c.tid = tid; c.lane = tid & 63; c.wave = __builtin_amdgcn_readfirstlane(tid >> 6); c.bid = bid; c.G = gridDim.x;
    c.gw = bid * NWAVES + c.wave; c.NGW = c.G * NWAVES; return c;
}

constexpr int SP_LD = 132;
template <class EpiS>
__device__ __forceinline__ void small_gemm(LAS unsigned char* lds, const bf16_t* A, int lda, const bf16_t* Bt, int ldb, int K, int N, const EpiS& E, const Ctx& c) {
    const int lane = c.lane, fr = lane & 15, fq = lane >> 4, w = c.wave;
    const int nct = N / 128, kw = K / 8;
    LAS float* P = (LAS float*)lds;
    for (int u = c.bid; u < 32 * nct; u += c.G) {
        const int ct = u % nct, rt = u / nct, r0 = 32 * rt, n0 = 128 * ct;
        f32x4 acc[2][8];
#pragma unroll
        for (int mt = 0; mt < 2; ++mt)
#pragma unroll
            for (int nt = 0; nt < 8; ++nt) acc[mt][nt] = (f32x4){0.f, 0.f, 0.f, 0.f};
        const bf16_t* ap = A + (size_t)(r0 + fr) * lda + w * kw + 8 * fq;
        const bf16_t* bp = Bt + (size_t)(n0 + fr) * ldb + w * kw + 8 * fq;
        bf16x8 a0[2], b0[8], a1[2], b1[8];
#define SG_LOAD(AF, BF, K0) do { _Pragma("unroll") for (int mt = 0; mt < 2; ++mt) AF[mt] = *(const bf16x8*)(ap + (size_t)16 * mt * lda + (K0)); \
        _Pragma("unroll") for (int nt = 0; nt < 8; ++nt) BF[nt] = *(const bf16x8*)(bp + (size_t)16 * nt * ldb + (K0)); } while (0)
#define SG_MMA(AF, BF) do { _Pragma("unroll") for (int mt = 0; mt < 2; ++mt) _Pragma("unroll") for (int nt = 0; nt < 8; ++nt) \
        acc[mt][nt] = __builtin_amdgcn_mfma_f32_16x16x32_bf16(BF[nt], AF[mt], acc[mt][nt], 0, 0, 0); } while (0)
        SG_LOAD(a0, b0, 0);
        for (int k0 = 0; k0 < kw; k0 += 64) {
            SG_LOAD(a1, b1, k0 + 32);
            SG_MMA(a0, b0);
            if (k0 + 64 < kw) SG_LOAD(a0, b0, k0 + 64);
            SG_MMA(a1, b1);
        }
#undef SG_LOAD
#undef SG_MMA
        LAS float* pw = P + w * 32 * SP_LD;
#pragma unroll
        for (int mt = 0; mt < 2; ++mt)
#pragma unroll
            for (int nt = 0; nt < 8; ++nt) *(LAS f32x4*)(pw + (16 * mt + fr) * SP_LD + 16 * nt + 4 * fq) = acc[mt][nt];
        __syncthreads();
        const int row = c.tid >> 4, c8 = (c.tid & 15) * 8;
        f32x4 v0 = (f32x4){0.f, 0.f, 0.f, 0.f}, v1 = v0;
#pragma unroll
        for (int ww = 0; ww < 8; ++ww) { v0 += *(const LAS f32x4*)(P + (ww * 32 + row) * SP_LD + c8); v1 += *(const LAS f32x4*)(P + (ww * 32 + row) * SP_LD + c8 + 4); }
        E(r0 + row, n0 + c8, v0, v1);
        __syncthreads();
    }
}
struct EpiSRes {
    float* X; const float* gate; const float* base;
    __device__ __forceinline__ void operator()(int row, int col, f32x4 v0, f32x4 v1) const {
        const float* gp = gate + (size_t)(2 + (row >> 3)) * MODLD + col;
        float* xp = X + (size_t)(MP + row) * 1024 + col;
        const float* bp = base + (size_t)row * 1024 + col;
        const f32x4 g0 = *(const f32x4*)gp, g1 = *(const f32x4*)(gp + 4);
        f32x4 x0 = *(const f32x4*)bp, x1 = *(const f32x4*)(bp + 4);
        x0 += g0 * v0; x1 += g1 * v1;
        *(f32x4*)xp = x0; *(f32x4*)(xp + 4) = x1;
    }
};
struct EpiSUp {
    bf16_t* O;
    __device__ __forceinline__ void operator()(int row, int col, f32x4 v0, f32x4 v1) const {
#pragma unroll
        for (int i = 0; i < 4; ++i) { const float a = fmaxf(v0[i], 0.f), b = fmaxf(v1[i], 0.f); v0[i] = a * a; v1[i] = b * b; }
        store8(O + (size_t)(MP + row) * FF + col, v0, v1);
    }
};
struct EpiSBranch {
    bf16_t* MG; const unsigned char* Gt; int first;
    __device__ __forceinline__ void operator()(int row, int col, f32x4 v0, f32x4 v1) const {
        const size_t r = (size_t)(MP + row);
        const u32x2 gw = *(const u32x2*)(Gt + r * 4096 + col);
        v0[0] *= ub(gw.x, 0); v0[1] *= ub(gw.x, 1); v0[2] *= ub(gw.x, 2); v0[3] *= ub(gw.x, 3);
        v1[0] *= ub(gw.y, 0); v1[1] *= ub(gw.y, 1); v1[2] *= ub(gw.y, 2); v1[3] *= ub(gw.y, 3);
        bf16_t* mp = MG + r * 1024 + col;
        if (!first) {
            const u32x4 mw = *(const u32x4*)mp;
            v0[0] += bflo(mw.x); v0[1] += bfhi(mw.x); v0[2] += bflo(mw.y); v0[3] += bfhi(mw.y);
            v1[0] += bflo(mw.z); v1[1] += bfhi(mw.z); v1[2] += bflo(mw.w); v1[3] += bfhi(mw.w);
        }
        store8(mp, v0, v1);
    }
};

__device__ __forceinline__ int perm_in(int s) {
    if (s >= 1536 && s < 2560) { const int o = s - 1536, bj = o >> 9, r = o & 511; return 1536 + ((r >> 7) << 8) + (bj << 7) + (r & 127); }
    if (s >= 3072 && s < 4096) { const int o = s - 3072, bj = o >> 9, r = o & 511; return 3072 + ((r >> 7) << 8) + (bj << 7) + (r & 127); }
    return s;
}
constexpr int TT_LD = 257;
__device__ __forceinline__ int transpose_tiles(const float* W, int K, int N, bf16_t* WT, int row_off, int mode, LAS float* tl, int base, int bid, int G, int tid) {
    const int ntn = N / 256, ntiles = (K / 64) * ntn, lane = tid & 63, wid = tid >> 6;
    int t = bid - base % G; if (t < 0) t += G;
    for (; t < ntiles; t += G) {
        const int kb = t / ntn, nb = t % ntn, k0 = 64 * kb, n0 = 256 * nb;
        float v[8][4];
#pragma unroll
        for (int i = 0; i < 8; ++i)
#pragma unroll
            for (int cc = 0; cc < 4; ++cc) v[i][cc] = __builtin_nontemporal_load(&W[(size_t)(k0 + 8 * wid + i) * N + n0 + 64 * cc + lane]);
#pragma unroll
        for (int i = 0; i < 8; ++i)
#pragma unroll
            for (int cc = 0; cc < 4; ++cc) tl[(8 * wid + i) * TT_LD + 64 * cc + lane] = v[i][cc];
        __syncthreads();
        const int ch = tid & 7;
#pragma unroll
        for (int qq = 0; qq < 4; ++qq) {
            const int n = (tid >> 3) + 64 * qq;
            const LAS float* sp = tl + (8 * ch) * TT_LD + n;
            u32x4 o; o.x = cvtpk(sp[0 * TT_LD], sp[1 * TT_LD]); o.y = cvtpk(sp[2 * TT_LD], sp[3 * TT_LD]); o.z = cvtpk(sp[4 * TT_LD], sp[5 * TT_LD]); o.w = cvtpk(sp[6 * TT_LD], sp[7 * TT_LD]);
            const int dn = row_off + (mode == 1 ? perm_in(n0 + n) : n0 + n);
            *(u32x4*)(WT + (size_t)dn * K + k0 + 8 * ch) = o;
        }
        __syncthreads();
    }
    return base + ntiles;
}

__device__ __forceinline__ void adaln_rows(const float* xp, const float* xs, float* Xcopy, bf16_t* Hout, const float* g, const float* shift, const float* scale, const Ctx& c) {
    constexpr int RPI = 5;
    f32x4 gg[4];
#pragma unroll
    for (int j = 0; j < 4; ++j) gg[j] = *(const f32x4*)(g + 4 * (c.lane + 64 * j));
    for (int row0 = RPI * c.gw; row0 < M; row0 += RPI * c.NGW) {
        f32x4 v[RPI][4]; float ss[RPI];
#pragma unroll
        for (int rr = 0; rr < RPI; ++rr) {
            const int row = min(row0 + rr, M - 1);
            const float* src = row < MP ? xp + (size_t)row * D : xs + (size_t)(row - MP) * D;
#pragma unroll
            for (int j = 0; j < 4; ++j) v[rr][j] = *(const f32x4*)(src + 4 * (c.lane + 64 * j));
        }
        const int bA = bidx(row0), bB = bidx(min(row0 + RPI - 1, M - 1));
        const bool same_b = bA == bB;
        f32x4 ps1[4], ps0[4];
        if (same_b) {
#pragma unroll
            for (int j = 0; j < 4; ++j) { ps1[j] = *(const f32x4*)(scale + (size_t)bA * MODLD + 4 * (c.lane + 64 * j)); ps0[j] = *(const f32x4*)(shift + (size_t)bA * MODLD + 4 * (c.lane + 64 * j)); }
        } else {
#pragma unroll
            for (int j = 0; j < 4; ++j) { ps1[j] = (f32x4){0.f, 0.f, 0.f, 0.f}; ps0[j] = ps1[j]; }
        }
#pragma unroll
        for (int rr = 0; rr < RPI; ++rr) {
            float a = 0.f;
#pragma unroll
            for (int j = 0; j < 4; ++j) a += (v[rr][j][0] * v[rr][j][0] + v[rr][j][1] * v[rr][j][1]) + (v[rr][j][2] * v[rr][j][2] + v[rr][j][3] * v[rr][j][3]);
            ss[rr] = a;
        }
#pragma unroll
        for (int o = 1; o < 64; o <<= 1)
#pragma unroll
            for (int rr = 0; rr < RPI; ++rr) ss[rr] += __shfl_xor(ss[rr], o);
#pragma unroll
        for (int rr = 0; rr < RPI; ++rr) {
            const int row = row0 + rr;
            if (row < M) {
                const int b = bidx(row);
                const float* sh = shift + (size_t)b * MODLD; const float* sc = scale + (size_t)b * MODLD;
                const float rstd = 1.0f / sqrtf(ss[rr] * (1.f / D) + EPS);
#pragma unroll
                for (int j = 0; j < 4; ++j) {
                    const int col = 4 * (c.lane + 64 * j);
                    if (Xcopy) *(f32x4*)(Xcopy + (size_t)row * D + col) = v[rr][j];
                    const f32x4 s1 = same_b ? ps1[j] : *(const f32x4*)(sc + col), s0 = same_b ? ps0[j] : *(const f32x4*)(sh + col);
                    const f32x4 o = v[rr][j] * rstd * gg[j] * (s1 + 1.0f) + s0;
                    u32x2 w; w.x = cvtpk(o[0], o[1]); w.y = cvtpk(o[2], o[3]);
                    *(u32x2*)(Hout + (size_t)row * D + col) = w;
                }
            }
        }
    }
}

struct C0P {
    bf16_t *Q, *KV, *VV; const bf16_t *GLU, *CGH;
    const float *qg, *kg, *lncg, *lncb, *cache_k, *cache_v, *state_a; float* out; int l;
};
__device__ __forceinline__ void phase_c0(const C0P& p, const Ctx& c) {
    const int lane = c.lane, hl = lane >> 4, e = lane & 15;
    const double invf[8] = {1.0, 0.19392274474868576, 0.03760603093086393, 0.007292664737217109, 0.001414213562373095, 0.0002742481756762073, 5.318295896944988e-05, 1.031338537721246e-05};
    const f32x4 kgg = *(const f32x4*)(p.kg + 4 * e);
    const f32x4 lg0 = *(const f32x4*)(p.lncg + 8 * lane), lg1 = *(const f32x4*)(p.lncg + 8 * lane + 4), lb0 = *(const f32x4*)(p.lncb + 8 * lane), lb1 = *(const f32x4*)(p.lncb + 8 * lane + 4);
    auto do_row = [&](int row, u32x2 wk, u32x2 wvr, u32x4 wvv) {
        const int pos = row < MP ? (row & (SEQ - 1)) : MP + ((row - MP) & 7);
        float cs[4], sn[4];
#pragma unroll
        for (int i = 0; i < 4; ++i) {
            const int fi = 4 * (e & 1) + i;
            double iv = invf[0];
#pragma unroll
            for (int k = 1; k < 8; ++k) iv = (fi == k) ? invf[k] : iv;
            const double rev = (double)pos * iv * 0.15915494309189535;
            const float fr = (float)(rev - __builtin_rint(rev));
            cs[i] = __builtin_amdgcn_cosf(fr); sn[i] = __builtin_amdgcn_sinf(fr);
        }
        long kvo = -1;
        if (row < MP) { const int t = row & (SEQ - 1); if (t >= SEQ - 128) kvo = ((long)(p.l * 2 + (row >> 13)) * 128 + (t - (SEQ - 128))) * 256; }
        else { const int bs = (row - MP) >> 3, t = (row - MP) & 7; kvo = ((long)(p.l * DECB + bs) * 128 + 120 + t) * 256; }
        const size_t ok_base = row < MP ? O_PK : O_SK, ov_base = row < MP ? O_PV : O_SV;
        {
            f32x4 x = {bflo(wk.x), bfhi(wk.x), bflo(wk.y), bfhi(wk.y)};
            float ss = (x[0] * x[0] + x[1] * x[1]) + (x[2] * x[2] + x[3] * x[3]);
            ss += __shfl_xor(ss, 1); ss += __shfl_xor(ss, 2); ss += __shfl_xor(ss, 4); ss += __shfl_xor(ss, 8);
            const float rstd = 1.0f / sqrtf(ss * (1.f / 64.f) + EPS);
            x = x * rstd * kgg;
            f32x4 pr;
#pragma unroll
            for (int i = 0; i < 4; ++i) pr[i] = __shfl_xor(x[i], 2);
            if (e < 4) {
#pragma unroll
                for (int i = 0; i < 4; ++i) x[i] = (e < 2) ? (x[i] * cs[i] - pr[i] * sn[i]) : (x[i] * cs[i] + pr[i] * sn[i]);
            }
            u32x2 o; o.x = cvtpk(x[0], x[1]); o.y = cvtpk(x[2], x[3]);
            *(u32x2*)(p.KV + (size_t)row * 512 + hl * 64 + 4 * e) = o;
            if (kvo >= 0) *(f32x4*)(p.out + ok_base + kvo + hl * 64 + 4 * e) = x;
        }
        if (kvo >= 0) *(f32x4*)(p.out + ov_base + kvo + hl * 64 + 4 * e) = (f32x4){bflo(wvr.x), bfhi(wvr.x), bflo(wvr.y), bfhi(wvr.y)};
        {
            bf16_t* vp = p.VV + (size_t)row * 512 + 8 * lane;
            const u32x4 w = wvv;
            float v[8] = {bflo(w.x), bfhi(w.x), bflo(w.y), bfhi(w.y), bflo(w.z), bfhi(w.z), bflo(w.w), bfhi(w.w)};
            float s = 0.f;
#pragma unroll
            for (int i = 0; i < 8; ++i) s += v[i];
            const float mean = wave_sum(s) * (1.f / 512.f);
            float q = 0.f;
#pragma unroll
            for (int i = 0; i < 8; ++i) { v[i] -= mean; q += v[i] * v[i]; }
            const float rstd = 1.0f / sqrtf(wave_sum(q) * (1.f / 512.f) + EPS);
            f32x4 o0, o1;
#pragma unroll
            for (int i = 0; i < 4; ++i) { o0[i] = v[i] * rstd * lg0[i] + lb0[i]; o1[i] = v[4 + i] * rstd * lg1[i] + lb1[i]; }
            store8(vp, o0, o1);
            if (row >= MP) { float* og = p.out + O_SG + ((size_t)p.l * MS + (row - MP)) * 512 + 8 * lane; *(f32x4*)og = o0; *(f32x4*)(og + 4) = o1; }
        }
    };
    constexpr int RP = 4;
    for (int row0 = RP * c.gw; row0 < M; row0 += RP * c.NGW) {
        u32x2 wk[RP], wv[RP]; u32x4 wvv[RP];
#pragma unroll
        for (int rr = 0; rr < RP; ++rr) {
            const size_t row = (size_t)(row0 + rr);
            wk[rr] = *(const u32x2*)(p.KV + row * 512 + hl * 64 + 4 * e); wv[rr] = *(const u32x2*)(p.KV + row * 512 + 256 + hl * 64 + 4 * e);
            wvv[rr] = *(const u32x4*)(p.VV + row * 512 + 8 * lane);
        }
#pragma unroll
        for (int rr = 0; rr < RP; ++rr) do_row(row0 + rr, wk[rr], wv[rr], wvv[rr]);
    }
    const long gt = (long)c.gw * 64 + c.lane, NT = (long)c.NGW * 64;
    for (long i = gt; i < 2 * 30 * 128; i += NT) {
        const int b = (int)(i / (30 * 128)), r = (int)(i % (30 * 128)), j = r >> 7, c4 = (r & 127) * 4;
        const u32x2 w = *(const u32x2*)(p.GLU + ((size_t)b * SEQ + SEQ - 30 + j) * 512 + c4);
        *(f32x4*)(p.out + O_PA + (((size_t)p.l * 2 + b) * 30 + j) * 512 + c4) = (f32x4){bflo(w.x), bfhi(w.x), bflo(w.y), bfhi(w.y)};
    }
    for (long i0 = gt; i0 < (long)DECB * 30 * 128; i0 += 4 * NT) {
        f32x4 v[4]; size_t dsts[4]; bool ok[4];
#pragma unroll
        for (int u4 = 0; u4 < 4; ++u4) {
            const long i = i0 + u4 * NT; ok[u4] = i < (long)DECB * 30 * 128;
            const long ii = ok[u4] ? i : 0;
            const int b = (int)(ii / (30 * 128)), r = (int)(ii % (30 * 128)), j = r >> 7, c4 = (r & 127) * 4;
            if (j < 22) v[u4] = *(const f32x4*)(p.state_a + (((size_t)p.l * DECB + b) * 30 + j + 8) * 512 + c4);
            else { const u32x2 w = *(const u32x2*)(p.GLU + ((size_t)MP + b * 8 + (j - 22)) * 512 + c4); v[u4] = (f32x4){bflo(w.x), bfhi(w.x), bflo(w.y), bfhi(w.y)}; }
            dsts[u4] = (((size_t)p.l * DECB + b) * 30 + j) * 512 + c4;
        }
#pragma unroll
        for (int u4 = 0; u4 < 4; ++u4) if (ok[u4]) *(f32x4*)(p.out + O_SA + dsts[u4]) = v[u4];
    }
    for (long i = gt; i < 2 * 2 * 128; i += NT) {
        const int b = (int)(i / 256), r = (int)(i % 256), j = r >> 7, c4 = (r & 127) * 4;
        const u32x2 w = *(const u32x2*)(p.CGH + ((size_t)b * SEQ + SEQ - 2 + j) * 512 + c4);
        *(f32x4*)(p.out + O_PB + (((size_t)p.l * 2 + b) * 2 + j) * 512 + c4) = (f32x4){bflo(w.x), bfhi(w.x), bflo(w.y), bfhi(w.y)};
    }
    for (long i = gt; i < (long)DECB * 2 * 128; i += NT) {
        const int b = (int)(i / 256), r = (int)(i % 256), j = r >> 7, c4 = (r & 127) * 4;
        const u32x2 w = *(const u32x2*)(p.CGH + ((size_t)MP + b * 8 + 6 + j) * 512 + c4);
        *(f32x4*)(p.out + O_SB + (((size_t)p.l * DECB + b) * 2 + j) * 512 + c4) = (f32x4){bflo(w.x), bfhi(w.x), bflo(w.y), bfhi(w.y)};
    }
}

constexpr int KS_LD = 72, VT_LD = 264;
constexpr int KS_BYTES = 256 * KS_LD * 2, VT_BYTES = 64 * VT_LD * 2;

template <bool SAMPLE>
__device__ __forceinline__ void attn_wave(const LAS bf16_t* Ks, const LAS bf16_t* Vt, int kbase, int kmin, bf16_t* Qb  ,
                                          const float* sinks  , const float* qg, int pos_base, int lane) {
    const int q = lane & 31, hi = lane >> 5;
    auto rowoff = [&](int r) -> size_t { return SAMPLE ? (size_t)(r & 7) * 1024 + (r >> 3) * 64 : (size_t)r * 1024; };
    const bf16_t* Qp = Qb + rowoff(q);
    const int lo = SAMPLE ? (q & 7) : q;
    const float sink = (SAMPLE ? sinks[q >> 3] : sinks[0]) * 1.4426950408889634f;
    bf16x8 qf[4];
#pragma unroll
    for (int d0 = 0; d0 < 4; ++d0) qf[d0] = *(const bf16x8*)(Qp + 16 * d0 + 8 * hi);
    {
        float x[4][8]; float ssq = 0.f;
#pragma unroll
        for (int d0 = 0; d0 < 4; ++d0)
#pragma unroll
            for (int j = 0; j < 8; ++j) { x[d0][j] = bf2f((bf16_t)qf[d0][j]); ssq += x[d0][j] * x[d0][j]; }
        f32x4 qg0[4], qg1[4];
#pragma unroll
        for (int d0 = 0; d0 < 4; ++d0) { qg0[d0] = *(const f32x4*)(qg + 16 * d0 + 8 * hi); qg1[d0] = *(const f32x4*)(qg + 16 * d0 + 8 * hi + 4); }
        ssq += __shfl_xor(ssq, 32);
        const float rstd = 1.0f / sqrtf(ssq * (1.f / 64.f) + EPS);
#pragma unroll
        for (int d0 = 0; d0 < 4; ++d0) {
#pragma unroll
            for (int j = 0; j < 4; ++j) { x[d0][j] *= rstd * qg0[d0][j]; x[d0][4 + j] *= rstd * qg1[d0][j]; }
        }
        const int pos = pos_base + (SAMPLE ? (q & 7) : q);
        const double invf[8] = {1.0, 0.19392274474868576, 0.03760603093086393, 0.007292664737217109, 0.001414213562373095, 0.0002742481756762073, 5.318295896944988e-05, 1.031338537721246e-05};
#pragma unroll
        for (int j = 0; j < 8; ++j) {
            const double rev = (double)pos * invf[j] * 0.15915494309189535;
            const float fr = (float)(rev - __builtin_rint(rev));
            const float cs = __builtin_amdgcn_cosf(fr), sn = __builtin_amdgcn_sinf(fr);
            const float pr = __shfl_xor(x[0][j], 32);
            x[0][j] = hi == 0 ? (x[0][j] * cs - pr * sn) : (x[0][j] * cs + pr * sn);
        }
#pragma unroll
        for (int d0 = 0; d0 < 4; ++d0) {
            u32x4 w; w.x = cvtpk(x[d0][0], x[d0][1]); w.y = cvtpk(x[d0][2], x[d0][3]); w.z = cvtpk(x[d0][4], x[d0][5]); w.w = cvtpk(x[d0][6], x[d0][7]);
            qf[d0] = __builtin_bit_cast(bf16x8, w);
        }
    }
    f32x16 s[5];
#pragma unroll
    for (int t = 0; t < 5; ++t) {
        s[t] = (f32x16){0.f, 0.f, 0.f, 0.f, 0.f, 0.f, 0.f, 0.f, 0.f, 0.f, 0.f, 0.f, 0.f, 0.f, 0.f, 0.f};
        const LAS bf16_t* kp = Ks + (kbase + 32 * t + q) * KS_LD + 8 * hi;
#pragma unroll
        for (int d0 = 0; d0 < 4; ++d0) { const bf16x8 kf = *(const LAS bf16x8*)(kp + 16 * d0); s[t] = __builtin_amdgcn_mfma_f32_32x32x16_bf16(kf, qf[d0], s[t], 0, 0, 0); }
        asm volatile("" ::: "memory");
    }
    const float sc = 0.125f * 1.4426950408889634f;
#pragma unroll
    for (int r = 0; r < 16; ++r) {
        const int k0 = crow(r, hi);
        s[0][r] = (k0 >= lo) ? s[0][r] : -1e30f;
        s[4][r] = (k0 <= lo) ? s[4][r] : -1e30f;
    }
    if (kmin > 0) {
#pragma unroll
        for (int t = 0; t < 5; ++t)
#pragma unroll
            for (int r = 0; r < 16; ++r) s[t][r] = (kbase + 32 * t + crow(r, hi) >= kmin) ? s[t][r] : -1e30f;
    }
    float mraw = -1e30f;
#pragma unroll
    for (int t = 0; t < 5; ++t)
#pragma unroll
        for (int r = 0; r < 16; ++r) mraw = fmaxf(mraw, s[t][r]);
    float mx = fmaxf(mraw * sc, sink);
    mx = fmaxf(mx, __shfl_xor(mx, 32));
    float sum = 0.f;
    f32x16 o[2];
    o[0] = (f32x16){0.f, 0.f, 0.f, 0.f, 0.f, 0.f, 0.f, 0.f, 0.f, 0.f, 0.f, 0.f, 0.f, 0.f, 0.f, 0.f}; o[1] = o[0];
#pragma unroll
    for (int t = 0; t < 5; ++t) {
#pragma unroll
        for (int cc = 0; cc < 2; ++cc) {
            float pv[8];
#pragma unroll
            for (int j = 0; j < 8; ++j) { pv[j] = __builtin_amdgcn_exp2f(fmaxf(s[t][8 * cc + j] * sc - mx, -126.f)); sum += pv[j]; }
            u32x4 pw; pw.x = cvtpk(pv[0], pv[1]); pw.y = cvtpk(pv[2], pv[3]); pw.z = cvtpk(pv[4], pv[5]); pw.w = cvtpk(pv[6], pv[7]);
            const bf16x8 pa = __builtin_bit_cast(bf16x8, pw);
#pragma unroll
            for (int dt = 0; dt < 2; ++dt) {
                const LAS bf16_t* vp = Vt + (32 * dt + q) * VT_LD + kbase + 32 * t + 16 * cc + 4 * hi;
                const s16x4 v0 = *(const LAS s16x4*)vp, v1 = *(const LAS s16x4*)(vp + 8);
                const bf16x8 vb = (bf16x8){v0[0], v0[1], v0[2], v0[3], v1[0], v1[1], v1[2], v1[3]};
                o[dt] = __builtin_amdgcn_mfma_f32_32x32x16_bf16(pa, vb, o[dt], 0, 0, 0);
            }
        }
        asm volatile("" ::: "memory");
    }
    sum += __shfl_xor(sum, 32);
    sum += __builtin_amdgcn_exp2f(sink - mx);
    const float inv = 1.0f / sum;
#pragma unroll
    for (int r = 0; r < 16; ++r) {
        const int qr = crow(r, hi);
        const float iv = __shfl(inv, qr);
        bf16_t* op = Qb + rowoff(qr) + q;
        op[0] = f2bf(o[0][r] * iv); op[32] = f2bf(o[1][r] * iv);
    }
}

struct C1P {
    bf16_t *Q, *BG, *U, *AACT; const bf16_t *KV, *GLU, *CGH, *VV, *WSP;
    const float *sinks, *cache_k, *cache_v, *state_a, *state_b, *conv_a_w, *conv_a_b, *ln_a_g, *ln_a_b, *conv_b_w, *w_sp, *b_sp; int l; const float* qg; float* out;
};

__device__ __forceinline__ void transpose8x8(const u32x4 (&r)[8], u32x4 (&o)[8]) {
#pragma unroll
    for (int j = 0; j < 8; ++j)
#pragma unroll
        for (int k = 0; k < 4; ++k) {
            const unsigned a = r[2 * k][j >> 1], b = r[2 * k + 1][j >> 1];
            o[j][k] = (j & 1) ? ((a >> 16) | (b & 0xffff0000u)) : ((a & 0xffffu) | (b << 16));
        }
}
__device__ __forceinline__ void vt_scatter(LAS bf16_t* Vt, int ld, int d0, int row, u32x4 vv) {
    Vt[(d0 + 0) * ld + row] = (bf16_t)(vv.x & 0xffffu); Vt[(d0 + 1) * ld + row] = (bf16_t)(vv.x >> 16);
    Vt[(d0 + 2) * ld + row] = (bf16_t)(vv.y & 0xffffu); Vt[(d0 + 3) * ld + row] = (bf16_t)(vv.y >> 16);
    Vt[(d0 + 4) * ld + row] = (bf16_t)(vv.z & 0xffffu); Vt[(d0 + 5) * ld + row] = (bf16_t)(vv.z >> 16);
    Vt[(d0 + 6) * ld + row] = (bf16_t)(vv.w & 0xffffu); Vt[(d0 + 7) * ld + row] = (bf16_t)(vv.w >> 16);
}

__device__ __forceinline__ void phase_attn(const C1P& p, LAS unsigned char* lds, const Ctx& c) {
    const int tid = c.tid, wid = c.wave, lane = c.lane;
    LAS bf16_t* Ks = (LAS bf16_t*)lds; LAS bf16_t* Vt = (LAS bf16_t*)(lds + KS_BYTES);
    for (int u = c.bid; u < 2 * 4 * 64; u += c.G) {
        const int i = u & 63, kvh = (u >> 6) & 3, b = u >> 8;
        {
            u32x4 kk[4], vr[8], vo[8];
#pragma unroll
            for (int it = 0; it < 4; ++it) {
                const int id = tid + 512 * it, row = id >> 3, ch = id & 7, pos = (i - 1) * 128 + row;
                kk[it] = (u32x4){0u, 0u, 0u, 0u};
                if (pos >= 0) kk[it] = *(const u32x4*)(p.KV + ((size_t)b * SEQ + pos) * 512 + kvh * 64 + ch * 8);
            }
            const int sb = tid & 31, db = tid >> 5;
            if (tid < 256) {
#pragma unroll
                for (int r8 = 0; r8 < 8; ++r8) {
                    const int pos = (i - 1) * 128 + 8 * sb + r8;
                    vr[r8] = (u32x4){0u, 0u, 0u, 0u};
                    if (pos >= 0) vr[r8] = *(const u32x4*)(p.KV + ((size_t)b * SEQ + pos) * 512 + 256 + kvh * 64 + db * 8);
                }
            }
#pragma unroll
            for (int it = 0; it < 4; ++it) { const int id = tid + 512 * it, row = id >> 3, ch = id & 7; *(LAS u32x4*)(Ks + row * KS_LD + ch * 8) = kk[it]; }
            if (tid < 256) {
                transpose8x8(vr, vo);
#pragma unroll
                for (int j = 0; j < 8; ++j) *(LAS u32x4*)(Vt + (8 * db + j) * VT_LD + 8 * sb) = vo[j];
            }
        }
        __syncthreads();
        const int head = kvh * 4 + (wid >> 1);
#pragma unroll 1
        for (int a2 = 0; a2 < 2; ++a2) {
            const int a = 2 * (wid & 1) + a2;
            attn_wave<false>(Ks, Vt, 32 * a, (i == 0) ? 128 : 0, p.Q + ((size_t)b * SEQ + i * 128 + 32 * a) * 1024 + head * 64, p.sinks + head, p.qg, i * 128 + 32 * a, lane);
        }
        __syncthreads();
    }
    constexpr int REG = KS_BYTES + VT_BYTES;
    for (int u = c.bid; u < DECB * 2; u += c.G) {
        const int b = u >> 1, kp = u & 1;
#pragma unroll
        for (int it = 0; it < 5; ++it) {
            const int id = tid + 512 * it;
            const int sel = id / 1280, rem = id % 1280, row = rem >> 3, ch = rem & 7, kvh = 2 * kp + sel;
            LAS bf16_t* Ks2 = (LAS bf16_t*)(lds + sel * REG);
            u32x4 kk = {0u, 0u, 0u, 0u};
            if (row < 128) {
                const size_t so = (((size_t)(p.l * DECB + b) * 128 + row) * 4 + kvh) * 64 + ch * 8;
                const f32x4 k0 = __builtin_nontemporal_load((const f32x4*)(p.cache_k + so)), k1 = __builtin_nontemporal_load((const f32x4*)(p.cache_k + so + 4));
                kk.x = cvtpk(k0[0], k0[1]); kk.y = cvtpk(k0[2], k0[3]); kk.z = cvtpk(k1[0], k1[1]); kk.w = cvtpk(k1[2], k1[3]);
                if (row >= 8) {
                    float* o = p.out + O_SK + (((size_t)(p.l * DECB + b) * 128 + (row - 8)) * 4 + kvh) * 64 + ch * 8; __builtin_nontemporal_store(k0, (f32x4*)o); __builtin_nontemporal_store(k1, (f32x4*)(o + 4)); }
            } else if (row < 136) {
                kk = *(const u32x4*)(p.KV + ((size_t)MP + b * 8 + (row - 128)) * 512 + kvh * 64 + ch * 8);
            }
            *(LAS u32x4*)(Ks2 + row * KS_LD + ch * 8) = kk;
        }
        if (tid < 320) {
            const int sel = tid / 160, rem = tid % 160, sb = rem % 20, db = rem / 20, kvh = 2 * kp + sel;
            LAS bf16_t* Vt2 = (LAS bf16_t*)(lds + sel * REG + KS_BYTES);
            u32x4 vr[8], vo[8];
            if (sb < 16) {
#pragma unroll
                for (int r8 = 0; r8 < 8; ++r8) {
                    const size_t so = (((size_t)(p.l * DECB + b) * 128 + 8 * sb + r8) * 4 + kvh) * 64 + db * 8;
                    const f32x4 v0 = __builtin_nontemporal_load((const f32x4*)(p.cache_v + so)), v1 = __builtin_nontemporal_load((const f32x4*)(p.cache_v + so + 4));
                    vr[r8].x = cvtpk(v0[0], v0[1]); vr[r8].y = cvtpk(v0[2], v0[3]); vr[r8].z = cvtpk(v1[0], v1[1]); vr[r8].w = cvtpk(v1[2], v1[3]);
                    if (sb >= 1) { float* o = p.out + O_SV + (((size_t)(p.l * DECB + b) * 128 + (8 * sb + r8 - 8)) * 4 + kvh) * 64 + db * 8; __builtin_nontemporal_store(v0, (f32x4*)o); __builtin_nontemporal_store(v1, (f32x4*)(o + 4)); }
                }
            } else if (sb == 16) {
#pragma unroll
                for (int r8 = 0; r8 < 8; ++r8) vr[r8] = *(const u32x4*)(p.KV + ((size_t)MP + b * 8 + r8) * 512 + 256 + kvh * 64 + db * 8);
            } else {
#pragma unroll
                for (int r8 = 0; r8 < 8; ++r8) vr[r8] = (u32x4){0u, 0u, 0u, 0u};
            }
            transpose8x8(vr, vo);
#pragma unroll
            for (int j = 0; j < 8; ++j) *(LAS u32x4*)(Vt2 + (8 * db + j) * VT_LD + 8 * sb) = vo[j];
        }
        __syncthreads();
        if (wid < 2) {
            const int kvh = 2 * kp + wid;
            attn_wave<true>((const LAS bf16_t*)(lds + wid * REG), (const LAS bf16_t*)(lds + wid * REG + KS_BYTES), 0, 0, p.Q + ((size_t)MP + b * 8) * 1024 + kvh * 256, p.sinks + kvh * 4, p.qg, MP, lane);
        }
        __syncthreads();
    }
}

template <int NOUT>
__device__ __forceinline__ void conv31(const f32x2v (&x)[NOUT + 30], const f32x2v (&w)[31], f32x2v bias, LAS float* dst  ) {
#pragma unroll
    for (int k = 0; k < NOUT; ++k) {
        f32x2v a = bias;
#pragma unroll
        for (int j = 0; j < 31; ++j) a += w[j] * x[k + j];
        *(LAS f32x2v*)(dst + k * 512) = a;
    }
}
__device__ __forceinline__ void phase_conva(const C1P& p, LAS unsigned char* lds, const Ctx& c) {
    const int tid = c.tid, wid = c.wave, lane = c.lane, c2 = tid & 255, h = tid >> 8;
    LAS float* buf = (LAS float*)lds;
    f32x2v w[31];
#pragma unroll
    for (int j = 0; j < 31; ++j) w[j] = *(const f32x2v*)(p.conv_a_w + ((size_t)p.l * 31 + j) * 512 + 2 * c2);
    const f32x2v bias = *(const f32x2v*)(p.conv_a_b + (size_t)p.l * 512 + 2 * c2);
    const f32x4 g0 = *(const f32x4*)(p.ln_a_g + (size_t)p.l * 512 + 8 * lane), g1 = *(const f32x4*)(p.ln_a_g + (size_t)p.l * 512 + 8 * lane + 4);
    const f32x4 b0 = *(const f32x4*)(p.ln_a_b + (size_t)p.l * 512 + 8 * lane), b1 = *(const f32x4*)(p.ln_a_b + (size_t)p.l * 512 + 8 * lane + 4);
    for (int ut = c.bid; ut < M / 64; ut += c.G) {
        const int R0 = 64 * ut;
        if (R0 < MP) {
#pragma unroll 1
            for (int ps = 0; ps < 2; ++ps) {
                const int tb = R0 + 32 * h + 16 * ps, ts = tb & (SEQ - 1);
                f32x2v x[46];
#pragma unroll
                for (int i = 0; i < 46; ++i) {
                    unsigned wv = 0u;
                    if (ts - 30 + i >= 0) wv = *(const unsigned*)(p.GLU + (size_t)(tb - 30 + i) * 512 + 2 * c2);
                    x[i] = (f32x2v){bflo(wv), bfhi(wv)};
                }
                conv31<16>(x, w, bias, buf + (32 * h + 16 * ps) * 512 + 2 * c2);
            }
        } else {
#pragma unroll 1
            for (int sq = 0; sq < 4; ++sq) {
                const int bs = (R0 - MP) / 8 + 4 * h + sq;
                f32x2v x[38];
#pragma unroll
                for (int i = 0; i < 30; ++i) x[i] = *(const f32x2v*)(p.state_a + (((size_t)p.l * DECB + bs) * 30 + i) * 512 + 2 * c2);
#pragma unroll
                for (int i = 0; i < 8; ++i) { const unsigned wv = *(const unsigned*)(p.GLU + ((size_t)MP + bs * 8 + i) * 512 + 2 * c2); x[30 + i] = (f32x2v){bflo(wv), bfhi(wv)}; }
                conv31<8>(x, w, bias, buf + (8 * (4 * h + sq)) * 512 + 2 * c2);
            }
        }
        __syncthreads();
#pragma unroll 4
        for (int k = 0; k < 8; ++k) {
            const int tok = 8 * wid + k;
            f32x4 v0 = *(const LAS f32x4*)(buf + tok * 512 + 8 * lane), v1 = *(const LAS f32x4*)(buf + tok * 512 + 8 * lane + 4);
            const float mean = wave_sum((v0[0] + v0[1]) + (v0[2] + v0[3]) + (v1[0] + v1[1]) + (v1[2] + v1[3])) * (1.f / 512.f);
            v0 -= mean; v1 -= mean;
            const float var = wave_sum((v0[0] * v0[0] + v0[1] * v0[1]) + (v0[2] * v0[2] + v0[3] * v0[3]) + (v1[0] * v1[0] + v1[1] * v1[1]) + (v1[2] * v1[2] + v1[3] * v1[3])) * (1.f / 512.f);
            const float rstd = 1.0f / sqrtf(var + EPS);
            f32x4 o0, o1;
#pragma unroll
            for (int i = 0; i < 4; ++i) { const float y0 = v0[i] * rstd * g0[i] + b0[i], y1 = v1[i] * rstd * g1[i] + b1[i]; o0[i] = y0 * sigm(y0); o1[i] = y1 * sigm(y1); }
            store8(p.AACT + (size_t)(R0 + tok) * 512 + 8 * lane, o0, o1);
        }
        __syncthreads();
    }
}

__device__ __forceinline__ void phase_convb(const C1P& p, const Ctx& c) {
    const long gt = (long)c.gw * 64 + c.lane, NT = (long)c.NGW * 64;
    const int c8 = (int)(gt & 63) * 8;
    f32x4 w0[2], w1[2], w2[2];
#pragma unroll
    for (int hh = 0; hh < 2; ++hh) {
        w0[hh] = *(const f32x4*)(p.conv_b_w + ((size_t)p.l * 3 + 0) * 512 + c8 + 4 * hh);
        w1[hh] = *(const f32x4*)(p.conv_b_w + ((size_t)p.l * 3 + 1) * 512 + c8 + 4 * hh);
        w2[hh] = *(const f32x4*)(p.conv_b_w + ((size_t)p.l * 3 + 2) * 512 + c8 + 4 * hh);
    }
    for (long i = gt; i < (long)(M / 8) * 64; i += NT) {
        const int r0 = (int)(i >> 6) * 8;
        u32x4 xw[10], bw[8];
        f32x4 h0[2], h1[2];
        const bool smp = r0 >= MP, seq0 = (r0 & (SEQ - 1)) == 0;
#pragma unroll
        for (int k = 0; k < 8; ++k) { xw[2 + k] = *(const u32x4*)(p.CGH + (size_t)(r0 + k) * 512 + c8); bw[k] = *(const u32x4*)(p.BG + (size_t)(r0 + k) * 512 + c8); }
        if (smp) {
            const float* st = p.state_b + ((size_t)p.l * DECB + ((r0 - MP) >> 3)) * 2 * 512 + c8;
            h0[0] = *(const f32x4*)st; h0[1] = *(const f32x4*)(st + 4); h1[0] = *(const f32x4*)(st + 512); h1[1] = *(const f32x4*)(st + 512 + 4);
        } else if (!seq0) {
            xw[0] = *(const u32x4*)(p.CGH + (size_t)(r0 - 2) * 512 + c8); xw[1] = *(const u32x4*)(p.CGH + (size_t)(r0 - 1) * 512 + c8);
        }
        f32x4 x[10][2];
#pragma unroll
        for (int k = 2; k < 10; ++k) { x[k][0] = (f32x4){bflo(xw[k].x), bfhi(xw[k].x), bflo(xw[k].y), bfhi(xw[k].y)}; x[k][1] = (f32x4){bflo(xw[k].z), bfhi(xw[k].z), bflo(xw[k].w), bfhi(xw[k].w)}; }
        if (smp) { x[0][0] = h0[0]; x[0][1] = h0[1]; x[1][0] = h1[0]; x[1][1] = h1[1]; }
        else if (!seq0) {
#pragma unroll
            for (int k = 0; k < 2; ++k) { x[k][0] = (f32x4){bflo(xw[k].x), bfhi(xw[k].x), bflo(xw[k].y), bfhi(xw[k].y)}; x[k][1] = (f32x4){bflo(xw[k].z), bfhi(xw[k].z), bflo(xw[k].w), bfhi(xw[k].w)}; }
        } else { const f32x4 z4 = {0.f, 0.f, 0.f, 0.f}; x[0][0] = z4; x[0][1] = z4; x[1][0] = z4; x[1][1] = z4; }
#pragma unroll
        for (int k = 0; k < 8; ++k) {
            const f32x4 bg0 = {bflo(bw[k].x), bfhi(bw[k].x), bflo(bw[k].y), bfhi(bw[k].y)}, bg1 = {bflo(bw[k].z), bfhi(bw[k].z), bflo(bw[k].w), bfhi(bw[k].w)};
            const f32x4 o0 = bg0 * (w0[0] * x[k][0] + w1[0] * x[k + 1][0] + w2[0] * x[k + 2][0]), o1 = bg1 * (w0[1] * x[k][1] + w1[1] * x[k + 1][1] + w2[1] * x[k + 2][1]);
            store8(p.BG + (size_t)(r0 + k) * 512 + c8, o0, o1);
        }
    }
}

constexpr int VVT_LD = 136;
__device__ __forceinline__ void phase_gmlp(const C1P& p, LAS unsigned char* lds, const Ctx& c) {
    const int tid = c.tid, wid = c.wave, lane = c.lane, q = lane & 31, hi = lane >> 5;
    LAS bf16_t* VVt = (LAS bf16_t*)lds;
    for (int u = c.bid; u < 128 * 2; u += c.G) {
        const int ci = u >> 1, hh = u & 1, tok0 = ci * 128;
        {
            const int sb = tid & 15, db = tid >> 4;
            u32x4 vr[8], vo[8];
#pragma unroll
            for (int r8 = 0; r8 < 8; ++r8) vr[r8] = *(const u32x4*)(p.VV + (size_t)(tok0 + 8 * sb + r8) * 512 + 256 * hh + db * 8);
            transpose8x8(vr, vo);
#pragma unroll
            for (int j = 0; j < 8; ++j) *(LAS u32x4*)(VVt + (8 * db + j) * VVT_LD + 8 * sb) = vo[j];
        }
        __syncthreads();
        const int gl = wid >> 1, dt = wid & 1, g = 4 * hh + gl;
        const bf16_t* Wg = p.WSP + ((size_t)(p.l * 8 + g) * 128) * 128;
        const float* bs = p.b_sp + (size_t)(p.l * 8 + g) * 128;
#pragma unroll
        for (int ti = 0; ti < 4; ++ti) {
            f32x16 acc = (f32x16){0.f, 0.f, 0.f, 0.f, 0.f, 0.f, 0.f, 0.f, 0.f, 0.f, 0.f, 0.f, 0.f, 0.f, 0.f, 0.f};
            bf16x8 af[8];
#pragma unroll
            for (int ks = 0; ks < 2 * ti + 2; ++ks) af[ks] = *(const bf16x8*)(Wg + (size_t)(32 * ti + q) * 128 + 16 * ks + 8 * hi);
            bf16_t uu[16]; float bb[16];
#pragma unroll
            for (int r = 0; r < 16; ++r) { const int t = 32 * ti + crow(r, hi); uu[r] = p.U[(size_t)(tok0 + t) * 512 + g * 64 + 32 * dt + q]; bb[r] = bs[t]; }
#pragma unroll
            for (int ks = 0; ks < 2 * ti + 2; ++ks) {
                const bf16x8 bv = *(const LAS bf16x8*)(VVt + (gl * 64 + 32 * dt + q) * VVT_LD + 16 * ks + 8 * hi);
                acc = __builtin_amdgcn_mfma_f32_32x32x16_bf16(af[ks], bv, acc, 0, 0, 0);
            }
#pragma unroll
            for (int r = 0; r < 16; ++r) {
                const int t = 32 * ti + crow(r, hi);
                p.U[(size_t)(tok0 + t) * 512 + g * 64 + 32 * dt + q] = f2bf(bf2f(uu[r]) * (acc[r] + bb[r]));
            }
        }
        __syncthreads();
    }
    const long gt = (long)c.gw * 64 + c.lane, NT = (long)c.NGW * 64;
    for (long i = gt; i < (long)DECB * 512; i += NT) {
        const int b = (int)(i >> 9), ch = (int)(i & 511), g = ch >> 6;
        const float* Wg = p.w_sp + ((size_t)(p.l * 8 + g) * 128) * 128;
        const float* bs = p.b_sp + (size_t)(p.l * 8 + g) * 128;
        float vv[8];
#pragma unroll
        for (int s = 0; s < 8; ++s) vv[s] = bf2f(p.VV[((size_t)MP + b * 8 + s) * 512 + ch]);
#pragma unroll
        for (int t = 0; t < 8; ++t) {
            float z = bs[t];
#pragma unroll
            for (int s = 0; s <= t; ++s) z += Wg[t * 128 + s] * vv[s];
            bf16_t* up = p.U + ((size_t)MP + b * 8 + t) * 512 + ch;
            *up = f2bf(bf2f(*up) * z);
        }
    }
}

#ifndef KMASK
#define KMASK 0xFFFF
#endif
#define KEN(k) ((KMASK >> (k)) & 1)
enum { I_XP = 0, I_XS, I_CP, I_CS, I_STA, I_STB, I_CK, I_CV, I_WADA, I_BADA, I_N1G, I_N2G, I_WIN, I_QNG, I_KNG, I_SINK, I_WAO, I_CAW, I_CAB, I_LAG, I_LAB,
       I_WAOUT, I_CBW, I_WBOUT, I_LCG, I_LCB, I_WSP, I_BSP, I_WCOUT, I_WO, I_WUP, I_WDN };

typedef const __attribute__((address_space(4))) Args* ArgsP;
__device__ __forceinline__ ArgsP get_args() { ArgsP ap = (ArgsP)__builtin_amdgcn_kernarg_segment_ptr(); asm volatile("" : "+s"(ap)); return ap; }
#define WSB(off) ((bf16_t*)(ws + (off)))
__device__ __forceinline__ C1P make_c1p(ArgsP a, int l) {
    unsigned char* ws = a->ws;
    C1P p{WSB(WS_Q), WSB(WS_BG), WSB(WS_U), WSB(WS_AACT), WSB(WS_KV), WSB(WS_GLU), WSB(WS_CGH), WSB(WS_VV), WSB(WS_WSP), a->in[I_SINK] + l * 16, a->in[I_CK], a->in[I_CV], a->in[I_STA], a->in[I_STB],
          a->in[I_CAW], a->in[I_CAB], a->in[I_LAG], a->in[I_LAB], a->in[I_CBW], a->in[I_WSP], a->in[I_BSP], l, a->in[I_QNG] + l * 64, a->out};
    return p;
}

__global__ void __launch_bounds__(NTHR, 2) mega_fwd(Args a_unused) {
    extern __shared__ __attribute__((aligned(16))) unsigned char lds_raw[];
    LAS unsigned char* lds = (LAS unsigned char*)lds_raw;
    cg::grid_group grid = cg::this_grid();
    const int nprog = get_args()->nprog;
    volatile LAS unsigned* MISC = (volatile LAS unsigned*)(lds + BAR_LDS_OFF);
    if (threadIdx.x < 16) MISC[threadIdx.x] = 0u;
    __syncthreads();
    const XcdBarrier bar = xcd_barrier_post((unsigned*)get_args()->ws, MISC);

    for (int pi = 0; pi < nprog; ++pi) {
        const int ph = get_args()->prog[pi];
        const Ctx c = make_ctx();
        LAS float* scr = (LAS float*)(lds + c.wave * 16384);
        const int l = ph < 2 ? 0 : (ph - 2) / 9, kind = ph == 255 ? 99 : (ph < 2 ? ph : 2 + (ph - 2) % 9);
        switch (kind) {
        case 0: if (KEN(0)) {
            ArgsP a = get_args(); unsigned char* ws = a->ws;
            { int tb = 0; for (int ll = 0; ll < NL; ++ll) tb = transpose_tiles(a->in[I_WADA] + (size_t)ll * D * 6144, D, 6144, WSB(WS_WADA), ll * 6144, 0, (LAS float*)lds, tb, c.bid, c.G, c.tid); }
            const long gt = (long)c.gw * 64 + c.lane, NT = (long)c.NGW * 64;
            bf16_t* CS = WSB(WS_CS); bf16_t* WSPB = WSB(WS_WSP);
            const float* cp = a->in[I_CP]; const float* csm = a->in[I_CS]; const float* wsp = a->in[I_WSP];
            for (long i = gt; i < 256 * 1024; i += NT) {
                const int r = (int)(i >> 10), col = (int)(i & 1023);
                float v = 0.f;
                if (r < 2) v = cp[r * D + col]; else if (r < NBROW) v = csm[(size_t)(r - 2) * D + col];
                CS[i] = f2bf(v * sigm(v));
            }
            for (long i = gt; i < (long)NL * 8 * 128 * 128; i += NT) {
                const int t = (int)(i >> 7) & 127, s = (int)i & 127;
                WSPB[i] = f2bf(s <= t ? wsp[i] : 0.f);
            }
        } break;
        case 1: if (KEN(1)) {
            ArgsP a = get_args(); unsigned char* ws = a->ws;
            pg8::Gemm g{WSB(WS_CS), WSB(WS_WADA), 256, MODLD, D, D, D}; pg8::StaticOrder S; S.init(256, MODLD, c.G, c.bid);
            epi::EpiMod E{(float*)(ws + WS_MOD), a->in[I_BADA]};
            pg8::gemm_phase<epi::EpiMod, pg8::StaticOrder, false, true>(lds, g, S, E, c.tid);
            if (c.bid >= 48) {
                int tb = 0; const int b2 = c.bid - 48, G2 = c.G - 48;
                { ArgsP a2 = get_args(); unsigned char* ws = a2->ws; tb = transpose_tiles(a2->in[I_WIN], D, NIN, WSB(WS_WIN), 0, 1, (LAS float*)lds, tb, b2, G2, c.tid); }
                { ArgsP a2 = get_args(); unsigned char* ws = a2->ws; tb = transpose_tiles(a2->in[I_WAO], D, D, WSB(WS_WAO), 0, 0, (LAS float*)lds, tb, b2, G2, c.tid); }
                { ArgsP a2 = get_args(); unsigned char* ws = a2->ws; tb = transpose_tiles(a2->in[I_WAOUT], 512, D, WSB(WS_WA), 0, 0, (LAS float*)lds, tb, b2, G2, c.tid); }
                { ArgsP a2 = get_args(); unsigned char* ws = a2->ws; tb = transpose_tiles(a2->in[I_WBOUT], 512, D, WSB(WS_WB), 0, 0, (LAS float*)lds, tb, b2, G2, c.tid); }
                { ArgsP a2 = get_args(); unsigned char* ws = a2->ws; tb = transpose_tiles(a2->in[I_WCOUT], 512, D, WSB(WS_WC), 0, 0, (LAS float*)lds, tb, b2, G2, c.tid); }
                { ArgsP a2 = get_args(); unsigned char* ws = a2->ws; tb = transpose_tiles(a2->in[I_WO], D, D, WSB(WS_WO), 0, 0, (LAS float*)lds, tb, b2, G2, c.tid); }
            }
        } break;
        case 2: if (KEN(2)) {
            if (l > 0) {
            int tb = 0;
            { ArgsP a = get_args(); unsigned char* ws = a->ws; tb = transpose_tiles(a->in[I_WIN] + (size_t)l * D * NIN, D, NIN, WSB(WS_WIN), 0, 1, (LAS float*)lds, tb, c.bid, c.G, c.tid); }
            { ArgsP a = get_args(); unsigned char* ws = a->ws; tb = transpose_tiles(a->in[I_WAO] + (size_t)l * D * D, D, D, WSB(WS_WAO), 0, 0, (LAS float*)lds, tb, c.bid, c.G, c.tid); }
            { ArgsP a = get_args(); unsigned char* ws = a->ws; tb = transpose_tiles(a->in[I_WAOUT] + (size_t)l * 512 * D, 512, D, WSB(WS_WA), 0, 0, (LAS float*)lds, tb, c.bid, c.G, c.tid); }
            { ArgsP a = get_args(); unsigned char* ws = a->ws; tb = transpose_tiles(a->in[I_WBOUT] + (size_t)l * 512 * D, 512, D, WSB(WS_WB), 0, 0, (LAS float*)lds, tb, c.bid, c.G, c.tid); }
            { ArgsP a = get_args(); unsigned char* ws = a->ws; tb = transpose_tiles(a->in[I_WCOUT] + (size_t)l * 512 * D, 512, D, WSB(WS_WC), 0, 0, (LAS float*)lds, tb, c.bid, c.G, c.tid); }
            { ArgsP a = get_args(); unsigned char* ws = a->ws; tb = transpose_tiles(a->in[I_WO] + (size_t)l * D * D, D, D, WSB(WS_WO), 0, 0, (LAS float*)lds, tb, c.bid, c.G, c.tid); }
            }
            { ArgsP a = get_args(); unsigned char* ws = a->ws; float* X = a->out;
              const float* md = (const float*)(ws + WS_MOD) + (size_t)l * 6144;
              const float* xp = l == 0 ? a->in[I_XP] : X; const float* xs = l == 0 ? a->in[I_XS] : X + (size_t)MP * D;
              adaln_rows(xp, xs, nullptr, WSB(WS_H), a->in[I_N1G] + l * D, md + 0 * D, md + 1 * D, c); }
        } break;
        case 3: if (KEN(3)) {
            ArgsP a = get_args(); unsigned char* ws = a->ws;
            pg8::Gemm g{WSB(WS_H), WSB(WS_WIN), M, NIN, D, D, D}; pg8::StaticOrder S; S.init(M, NIN, c.G, c.bid);
            epi::EpiIn E{WSB(WS_Q), WSB(WS_KV), WSB(WS_GLU), WSB(WS_BG), WSB(WS_CGH), WSB(WS_U), WSB(WS_VV), WSB(WS_G)};
            pg8::gemm_phase<epi::EpiIn, pg8::StaticOrder, true, true>(lds, g, S, E, c.tid);
        } break;
        case 4: if (KEN(4)) {
            ArgsP a = get_args(); unsigned char* ws = a->ws;
            C0P p{WSB(WS_Q), WSB(WS_KV), WSB(WS_VV), WSB(WS_GLU), WSB(WS_CGH), a->in[I_QNG] + l * 64, a->in[I_KNG] + l * 64, a->in[I_LCG] + l * 512, a->in[I_LCB] + l * 512, a->in[I_CK], a->in[I_CV], a->in[I_STA], a->out, l};
            phase_c0(p, c);
        } break;
        case 5: if (KEN(5)) {
#ifndef SMASK
#define SMASK 15
#endif
            if (SMASK & 1) { const Ctx c1 = make_ctx(); const C1P p = make_c1p(get_args(), l); phase_attn(p, lds, c1); }
            if (SMASK & 2) { const Ctx c1 = make_ctx(); const C1P p = make_c1p(get_args(), l); phase_conva(p, lds, c1); }
            if (SMASK & 4) { const Ctx c1 = make_ctx(); const C1P p = make_c1p(get_args(), l); phase_convb(p, c1); }
            if (SMASK & 8) { const Ctx c1 = make_ctx(); const C1P p = make_c1p(get_args(), l); phase_gmlp(p, lds, c1); }
        } break;
        case 6: if (KEN(6)) {
            const bool odd = (blockIdx.x & 1) != 0;
#pragma unroll 1
            for (int st = 0; st < 6; ++st) {
                const Ctx c = make_ctx();
                const int op = !odd ? st : (st == 0 ? 1 : st == 1 ? 0 : st == 5 ? 2 : st + 1);
                ArgsP a = get_args(); unsigned char* ws = a->ws;
                if (op == 0) {
                    pg8::Gemm g{WSB(WS_Q), WSB(WS_WAO), MP, D, D, D, D}; pg8::StaticOrder S; S.init(MP, D, c.G, c.bid);
                    epi::EpiBranch E{WSB(WS_MG), (const unsigned char*)(ws + WS_G), 0};
                    pg8::gemm_phase<epi::EpiBranch, pg8::StaticOrder, true, true>(lds, g, S, E, c.tid);
                } else if (op == 2) {
                    pg8::Gemm g{WSB(WS_AACT), WSB(WS_WA), MP, D, 512, 512, 512};
                    epi::BranchOrder S; S.so.init(MP, D, c.G, c.bid);
                    S.A0 = WSB(WS_AACT); S.A1 = WSB(WS_BG); S.A2 = WSB(WS_U); S.B0 = WSB(WS_WA); S.B1 = WSB(WS_WB); S.B2 = WSB(WS_WC);
                    epi::EpiBranch E{WSB(WS_MG), (const unsigned char*)(ws + WS_G), 1};
                    pg8::gemm_phase<epi::EpiBranch, epi::BranchOrder, true, true>(lds, g, S, E, c.tid);
                } else {
                    const int br = op == 1 ? 0 : op - 2;
                    const bf16_t* A = br == 0 ? WSB(WS_Q) : br == 1 ? WSB(WS_AACT) : br == 2 ? WSB(WS_BG) : WSB(WS_U);
                    const bf16_t* Bt = br == 0 ? WSB(WS_WAO) : br == 1 ? WSB(WS_WA) : br == 2 ? WSB(WS_WB) : WSB(WS_WC);
                    const int K = br == 0 ? 1024 : 512;
                    EpiSBranch ES{WSB(WS_MG), (const unsigned char*)(ws + WS_G) + br * 1024, br == 0 ? 1 : 0};
                    small_gemm(lds, A + (size_t)MP * K, K, Bt, K, K, D, ES, c);
                }
            }
        } break;
        case 7: case 10: if (KEN(7)) {
            const bool dn = kind == 10;
#pragma unroll 1
            for (int st = 0; st < 2; ++st) {
                const Ctx c = make_ctx();
                ArgsP a = get_args(); unsigned char* ws = a->ws;
                const int K = dn ? FF : D;
                const bf16_t* A = dn ? WSB(WS_G) : WSB(WS_MG); const bf16_t* Bt = dn ? WSB(WS_WDN) : WSB(WS_WO);
                const float* gate = (const float*)(ws + WS_MOD) + (size_t)l * 6144 + (dn ? 5 : 2) * D;
                if ((st ^ (c.bid & 1)) == 0) {
                    pg8::Gemm g{A, Bt, MP, D, K, K, K}; pg8::StaticOrder S; S.init(MP, D, c.G, c.bid);
                    epi::EpiRes E{a->out, gate, (!dn && l == 0) ? a->in[I_XP] : (const float*)a->out};
                    pg8::gemm_phase<epi::EpiRes, pg8::StaticOrder, true, true>(lds, g, S, E, c.tid);
                } else {
                    EpiSRes ES{a->out, gate, (!dn && l == 0) ? a->in[I_XS] : (const float*)a->out + (size_t)MP * D};
                    small_gemm(lds, A + (size_t)MP * K, K, Bt, K, K, D, ES, c);
                }
            }
        } break;
        case 8: if (KEN(8)) {
            if (true) {
            int tb = 0;
            { ArgsP a = get_args(); unsigned char* ws = a->ws; tb = transpose_tiles(a->in[I_WUP] + (size_t)l * D * FF, D, FF, WSB(WS_WUP), 0, 0, (LAS float*)lds, tb, c.bid, c.G, c.tid); }
            { ArgsP a = get_args(); unsigned char* ws = a->ws; tb = transpose_tiles(a->in[I_WDN] + (size_t)l * FF * D, FF, D, WSB(WS_WDN), 0, 0, (LAS float*)lds, tb, c.bid, c.G, c.tid); }
            }
            { ArgsP a = get_args(); unsigned char* ws = a->ws; float* X = a->out;
              const float* md = (const float*)(ws + WS_MOD) + (size_t)l * 6144;
              adaln_rows(X, X + (size_t)MP * D, nullptr, WSB(WS_H), a->in[I_N2G] + l * D, md + 3 * D, md + 4 * D, c); }
        } break;
        case 9: if (KEN(9)) {
            ArgsP a = get_args(); unsigned char* ws = a->ws;
            pg8::Gemm g{WSB(WS_H), WSB(WS_WUP), MP, FF, D, D, D}; pg8::StaticOrder S; S.init(MP, FF, c.G, c.bid);
            epi::EpiUp E{WSB(WS_G), FF};
            pg8::gemm_phase<epi::EpiUp, pg8::StaticOrder, true, true>(lds, g, S, E, c.tid);
            EpiSUp ES{WSB(WS_G)};
            small_gemm(lds, WSB(WS_H) + (size_t)MP * D, D, WSB(WS_WUP), D, D, FF, ES, c);
        } break;
        default: break;
        }
        if (pi + 1 < nprog) { if (nprog > 200) grid.sync(); xcd_barrier(bar); }
    }
}

constexpr int NPHASES = 2 + 9 * NL;

extern "C" void kernel_launch(void* const* d_in, const int* in_sizes, int n_in, void* d_out, int out_size, void* d_ws, size_t ws_size, hipStream_t stream) {
    static int grid = 0;
    if (grid == 0) {
        if (n_in != 32 || ws_size < WS_END) { fprintf(stderr, "kernel_launch: unexpected n_in %d / ws_size %zu (need %zu)\n", n_in, ws_size, (size_t)WS_END); grid = -1; return; }
        int dev = 0, cus = 0, per_cu = 0;
        hipGetDevice(&dev); hipDeviceGetAttribute(&cus, hipDeviceAttributeMultiprocessorCount, dev);
        hipFuncSetAttribute((const void*)mega_fwd, hipFuncAttributeMaxDynamicSharedMemorySize, LDS_BYTES);
        hipOccupancyMaxActiveBlocksPerMultiprocessor(&per_cu, (const void*)mega_fwd, NTHR, LDS_BYTES);
        (void)hipGetLastError();
        if (per_cu < 1) per_cu = 1;
        grid = cus * per_cu;
    }
    if (grid < 0) return;
    Args a{};
    for (int i = 0; i < 32; ++i) a.in[i] = (const float*)d_in[i];
    a.out = (float*)d_out; a.ws = (unsigned char*)d_ws;
    int n = 0;
#ifndef PROBE
#define PROBE 0
#endif
    for (int ph = 0; ph < NPHASES; ++ph) {
        const int k = ph < 2 ? ph : 2 + (ph - 2) % 9;
        a.prog[n++] = (unsigned char)ph;
        if (PROBE == 1 && (k == 3 || k == 6 || k == 9)) a.prog[n++] = (unsigned char)ph;
        if (PROBE == 2 && (k == 2 || k == 8)) a.prog[n++] = (unsigned char)ph;
        if (PROBE == 2 && k == 1) { a.prog[n++] = 0; a.prog[n++] = 1; }
        if (PROBE == 3 && k == 5) { a.prog[n++] = (unsigned char)(ph - 3); a.prog[n++] = (unsigned char)(ph - 2); a.prog[n++] = (unsigned char)(ph - 1); a.prog[n++] = (unsigned char)ph; }
        if (PROBE == 4) a.prog[n++] = 255;
    }
    a.nprog = n;
    (void)hipMemsetAsync(d_ws, 0, BAR_BYTES, stream);
    void* args[] = {&a};
    hipError_t e = hipLaunchCooperativeKernel((const void*)mega_fwd, dim3(grid), dim3(NTHR), args, LDS_BYTES, stream);
    if (e != hipSuccess) fprintf(stderr, "cooperative launch failed: %s (grid %d)\n", hipGetErrorString(e), grid);
}
```
